# Optimizing an MI355X kernel written in HIP

```python
import jax, jax.numpy as jnp
from jax import lax
import numpy as np

D_MODEL = 1024
BATCH = 4
SEQ = 4096
DEPTH = 1

HEAD_DIM = 64
MIX_WIDTH = D_MODEL
NSA_WIDTH = MIX_WIDTH // 2
DSA_WIDTH = MIX_WIDTH - NSA_WIDTH
NSA_HEADS = NSA_WIDTH // HEAD_DIM
NSA_KV_HEADS = 2
NSA_KV_W = NSA_KV_HEADS * HEAD_DIM
DSA_HEADS = DSA_WIDTH // HEAD_DIM
DSA_KV_HEADS = 2
DSA_KV_W = DSA_KV_HEADS * HEAD_DIM
IDX_HEADS = 4
IDX_DIM = 64
CMP_BLOCK = 32
CMP_STRIDE = 16
CMP_HIDDEN = 256
SEL_BLOCK = 64
SEL_TOPN = 16
WINDOW = 512
DSA_TOPK_MAX = 256
ROPE_THETA = 10000.0
EPS = 1e-6
Q_BLOCK = 128
SEL_Q_BLOCK = 64
NEG = -1e30
FORCE = 1e6
ATTN_SCALE = HEAD_DIM ** -0.5

IN_WIDTHS = (NSA_WIDTH, NSA_KV_W, NSA_KV_W, NSA_KV_W, NSA_KV_W, NSA_KV_W, NSA_KV_W,
             3 * NSA_HEADS, NSA_WIDTH,
             DSA_WIDTH, DSA_KV_W, DSA_KV_W, IDX_HEADS * IDX_DIM, IDX_DIM, IDX_HEADS, DSA_WIDTH)
IN_COLS = sum(IN_WIDTHS)

kernel_name = "hymba_nsa_dsa_hybrid_layer"


def rms_norm(x, gain):
    xf = x.astype(jnp.float32)
    y = xf * lax.rsqrt(jnp.mean(xf * xf, axis=-1, keepdims=True) + EPS)
    return (y * gain.astype(jnp.float32)).astype(x.dtype)


def rope(x, pos):
    half = x.shape[-1] // 2
    inv_freq = ROPE_THETA ** (-jnp.arange(half, dtype=jnp.float32) / half)
    ang = pos[:, None] * inv_freq[None, :]
    cos = jnp.cos(ang)[:, None, :]
    sin = jnp.sin(ang)[:, None, :]
    xf = x.astype(jnp.float32)
    x1, x2 = xf[..., :half], xf[..., half:]
    return jnp.concatenate([x1 * cos - x2 * sin, x2 * cos + x1 * sin], axis=-1).astype(x.dtype)


def masked_softmax(s, mask):
    s = jnp.where(mask, s.astype(jnp.float32), NEG)
    p = jax.nn.softmax(s, axis=-1)
    return jnp.where(mask, p, 0.0)


def split_columns(proj, widths):
    offsets = np.cumsum(np.array(widths))[:-1]
    return jnp.split(proj, [int(o) for o in offsets], axis=-1)


def compress(k_raw, pe, w1, b1, w2):
    B, S, G, Dh = k_raw.shape
    n_cmp = (S - CMP_BLOCK) // CMP_STRIDE + 1
    idx = jnp.arange(n_cmp)[:, None] * CMP_STRIDE + jnp.arange(CMP_BLOCK)[None, :]
    blocks = k_raw[:, idx] + pe[None, None, :, None, :]
    flat = blocks.transpose(0, 1, 3, 2, 4).reshape(B, n_cmp, G, CMP_BLOCK * Dh)
    hid = jax.nn.silu(flat @ w1 + b1)
    return hid @ w2


def compressed_branch(q, kc, vc):
    S = q.shape[1]
    n_cmp = kc.shape[1]
    cmp_end = jnp.arange(n_cmp) * CMP_STRIDE + CMP_BLOCK - 1
    t = jnp.arange(S)
    s = jnp.einsum('bsgrd,bcgd->bgrsc', q, kc) * ATTN_SCALE
    p = masked_softmax(s, cmp_end[None, :] <= t[:, None])
    o = jnp.einsum('bgrsc,bcgd->bsgrd', p.astype(vc.dtype), vc)
    return o, p


def selection_indices(p_cmp):
    S, n_cmp = p_cmp.shape[-2], p_cmp.shape[-1]
    n_sel = S // SEL_BLOCK
    c_start = jnp.arange(n_cmp) * CMP_STRIDE
    j = jnp.arange(n_sel)
    j_start = j * SEL_BLOCK
    overlap = jnp.clip(jnp.minimum(c_start[:, None] + CMP_BLOCK, j_start[None, :] + SEL_BLOCK)
                       - jnp.maximum(c_start[:, None], j_start[None, :]), 0, None)
    overlap = overlap.astype(jnp.float32) / CMP_BLOCK
    imp = jnp.einsum('bgrsc,cj->bgsj', p_cmp, overlap)
    t = jnp.arange(S)
    cur = t // SEL_BLOCK
    forced = (j[None, :] == 0) | (j[None, :] == cur[:, None]) | (j[None, :] == cur[:, None] - 1)
    imp = jnp.where(forced, FORCE, imp)
    imp = jnp.where(j_start[None, :] <= t[:, None], imp, NEG)
    _, idx = lax.top_k(imp, min(SEL_TOPN, n_sel))
    return idx.transpose(0, 2, 1, 3)


def selected_branch(q, ks, vs, sel_idx):
    B, S, G, R, Dh = q.shape
    n_sel = S // SEL_BLOCK
    n = sel_idx.shape[-1]
    k_blocks = ks.reshape(B, n_sel, SEL_BLOCK, G, Dh).transpose(0, 3, 1, 2, 4)
    v_blocks = vs.reshape(B, n_sel, SEL_BLOCK, G, Dh).transpose(0, 3, 1, 2, 4)
    b_ix = jnp.arange(B)[:, None, None, None]
    g_ix = jnp.arange(G)[None, None, :, None]

    def one_block(i):
        t0 = i * SEL_Q_BLOCK
        q_b = lax.dynamic_slice_in_dim(q, t0, SEL_Q_BLOCK, axis=1)
        idx_b = lax.dynamic_slice_in_dim(sel_idx, t0, SEL_Q_BLOCK, axis=1)
        k_sel = k_blocks[b_ix, g_ix, idx_b].reshape(B, SEL_Q_BLOCK, G, n * SEL_BLOCK, Dh)
        v_sel = v_blocks[b_ix, g_ix, idx_b].reshape(B, SEL_Q_BLOCK, G, n * SEL_BLOCK, Dh)
        kpos = (idx_b[..., None] * SEL_BLOCK + jnp.arange(SEL_BLOCK)).reshape(B, SEL_Q_BLOCK, G, n * SEL_BLOCK)
        t = t0 + jnp.arange(SEL_Q_BLOCK)
        mask = (kpos <= t[None, :, None, None])[:, :, :, None, :]
        s = jnp.einsum('btgrd,btgkd->btgrk', q_b, k_sel) * ATTN_SCALE
        p = masked_softmax(s, mask)
        return jnp.einsum('btgrk,btgkd->btgrd', p.astype(v_sel.dtype), v_sel)

    out = lax.map(one_block, jnp.arange(S // SEL_Q_BLOCK))
    return out.transpose(1, 0, 2, 3, 4, 5).reshape(B, S, G, R, Dh)


def window_branch(q, kw, vw):
    B, S, G, R, Dh = q.shape
    pad = ((0, 0), (WINDOW, 0), (0, 0), (0, 0))
    kp = jnp.pad(kw, pad)
    vp = jnp.pad(vw, pad)
    span = Q_BLOCK + WINDOW

    def one_block(i):
        t0 = i * Q_BLOCK
        q_b = lax.dynamic_slice_in_dim(q, t0, Q_BLOCK, axis=1)
        k_b = lax.dynamic_slice_in_dim(kp, t0, span, axis=1)
        v_b = lax.dynamic_slice_in_dim(vp, t0, span, axis=1)
        kpos = t0 - WINDOW + jnp.arange(span)
        t = t0 + jnp.arange(Q_BLOCK)
        diff = t[:, None] - kpos[None, :]
        mask = (diff >= 0) & (diff < WINDOW) & (kpos[None, :] >= 0)
        s = jnp.einsum('btgrd,bkgd->bgrtk', q_b, k_b) * ATTN_SCALE
        p = masked_softmax(s, mask)
        return jnp.einsum('bgrtk,bkgd->btgrd', p.astype(v_b.dtype), v_b)

    out = lax.map(one_block, jnp.arange(S // Q_BLOCK))
    return out.transpose(1, 0, 2, 3, 4, 5).reshape(B, S, G, R, Dh)


def dsa_branch(q, k, v, qi, ki, wi):
    B, S, G, R, Dh = q.shape
    topk = min(DSA_TOPK_MAX, S // 4)
    b_ix = jnp.arange(B)[:, None, None]
    key_pos = jnp.arange(S)
    wi = wi * (IDX_HEADS ** -0.5)

    def one_block(i):
        t0 = i * Q_BLOCK
        q_b = lax.dynamic_slice_in_dim(q, t0, Q_BLOCK, axis=1)
        qi_b = lax.dynamic_slice_in_dim(qi, t0, Q_BLOCK, axis=1)
        wi_b = lax.dynamic_slice_in_dim(wi, t0, Q_BLOCK, axis=1)
        t = t0 + jnp.arange(Q_BLOCK)
        logits = jnp.einsum('bthd,bsd->bths', qi_b, ki) * (IDX_DIM ** -0.5)
        score = jnp.einsum('bths,bth->bts', jax.nn.relu(logits), wi_b).astype(jnp.float32)
        score = jnp.where(key_pos[None, None, :] <= t[None, :, None], score, NEG)
        _, idx = lax.top_k(score, topk)
        k_sel = k[b_ix, idx]
        v_sel = v[b_ix, idx]
        mask = (idx <= t[None, :, None])[:, :, None, None, :]
        s = jnp.einsum('btgrd,btkgd->btgrk', q_b, k_sel) * ATTN_SCALE
        p = masked_softmax(s, mask)
        return jnp.einsum('btgrk,btkgd->btgrd', p.astype(v_sel.dtype), v_sel)

    out = lax.map(one_block, jnp.arange(S // Q_BLOCK))
    return out.transpose(1, 0, 2, 3, 4, 5).reshape(B, S, G, R, Dh)


def hybrid_layer(x, norm_gain, w_in, nsa_q_gain, nsa_kc_gain, nsa_ks_gain, nsa_kw_gain,
                 cmp_pe_k, cmp_k_w1, cmp_k_b1, cmp_k_w2, cmp_pe_v, cmp_v_w1, cmp_v_b1, cmp_v_w2,
                 dsa_q_gain, dsa_k_gain, w_out):
    B, S, _ = x.shape
    pos = jnp.arange(S, dtype=jnp.float32)
    h = rms_norm(x, norm_gain)
    proj = jnp.einsum('bsd,dc->bsc', h, w_in)
    (q_n, kc, vc, ks, vs, kw, vw, gate_logits, z_n,
     q_d, k_d, v_d, qi, ki, wi, z_d) = split_columns(proj, IN_WIDTHS)

    def heads(a, n):
        return a.reshape(B, S, n, HEAD_DIM)

    G, R = NSA_KV_HEADS, NSA_HEADS // NSA_KV_HEADS
    qn = rope(rms_norm(heads(q_n, NSA_HEADS), nsa_q_gain), pos).reshape(B, S, G, R, HEAD_DIM)
    kc_cmp = compress(heads(kc, G), cmp_pe_k, cmp_k_w1, cmp_k_b1, cmp_k_w2)
    vc_cmp = compress(heads(vc, G), cmp_pe_v, cmp_v_w1, cmp_v_b1, cmp_v_w2)
    cmp_pos = (jnp.arange(kc_cmp.shape[1]) * CMP_STRIDE + CMP_BLOCK - 1).astype(jnp.float32)
    kc_cmp = rope(rms_norm(kc_cmp, nsa_kc_gain), cmp_pos)
    o_cmp, p_cmp = compressed_branch(qn, kc_cmp, vc_cmp)
    sel_idx = selection_indices(p_cmp)
    ks_r = rope(rms_norm(heads(ks, G), nsa_ks_gain), pos)
    o_sel = selected_branch(qn, ks_r, heads(vs, G), sel_idx)
    kw_r = rope(rms_norm(heads(kw, G), nsa_kw_gain), pos)
    o_win = window_branch(qn, kw_r, heads(vw, G))
    g = jax.nn.sigmoid(gate_logits.astype(jnp.float32)).reshape(B, S, G, R, 3).astype(o_cmp.dtype)
    o_nsa = g[..., 0:1] * o_cmp + g[..., 1:2] * o_sel + g[..., 2:3] * o_win
    o_nsa = o_nsa.reshape(B, S, NSA_WIDTH) * jax.nn.silu(z_n)

    Gd, Rd = DSA_KV_HEADS, DSA_HEADS // DSA_KV_HEADS
    qd = rope(rms_norm(heads(q_d, DSA_HEADS), dsa_q_gain), pos).reshape(B, S, Gd, Rd, HEAD_DIM)
    kd = rope(rms_norm(heads(k_d, Gd), dsa_k_gain), pos)
    qi_r = rope(qi.reshape(B, S, IDX_HEADS, IDX_DIM), pos)
    ki_r = rope(ki.reshape(B, S, 1, IDX_DIM), pos).reshape(B, S, IDX_DIM)
    o_dsa = dsa_branch(qd, kd, heads(v_d, Gd), qi_r, ki_r, wi)
    o_dsa = o_dsa.reshape(B, S, DSA_WIDTH) * jax.nn.silu(z_d)

    mixed = jnp.concatenate([o_nsa, o_dsa], axis=-1)
    return x + jnp.einsum('bsc,cd->bsd', mixed, w_out)


def setup_inputs(seed: int = 0) -> dict:
    key = jax.random.key(seed)
    k = jax.random.split(key, 18)
    L = DEPTH
    Dh = HEAD_DIM

    def nrm(kk, shape, scale):
        return jax.random.normal(kk, shape, jnp.float32) * scale

    def gain(kk, n):
        return 1.0 + 0.01 * jax.random.normal(kk, (L, n), jnp.float32)

    return {
        "x": nrm(k[0], (BATCH, SEQ, D_MODEL), 1.0),
        "norm_gain": gain(k[1], D_MODEL),
        "w_in": nrm(k[2], (L, D_MODEL, IN_COLS), D_MODEL ** -0.5),
        "nsa_q_gain": gain(k[3], Dh),
        "nsa_kc_gain": gain(k[4], Dh),
        "nsa_ks_gain": gain(k[5], Dh),
        "nsa_kw_gain": gain(k[6], Dh),
        "cmp_pe_k": nrm(k[7], (L, CMP_BLOCK, Dh), 0.1),
        "cmp_k_w1": nrm(k[8], (L, CMP_BLOCK * Dh, CMP_HIDDEN), (CMP_BLOCK * Dh) ** -0.5),
        "cmp_k_b1": nrm(k[9], (L, CMP_HIDDEN), 0.01),
        "cmp_k_w2": nrm(k[10], (L, CMP_HIDDEN, Dh), CMP_HIDDEN ** -0.5),
        "cmp_pe_v": nrm(k[11], (L, CMP_BLOCK, Dh), 0.1),
        "cmp_v_w1": nrm(k[12], (L, CMP_BLOCK * Dh, CMP_HIDDEN), (CMP_BLOCK * Dh) ** -0.5),
        "cmp_v_b1": nrm(k[13], (L, CMP_HIDDEN), 0.01),
        "cmp_v_w2": nrm(k[14], (L, CMP_HIDDEN, Dh), CMP_HIDDEN ** -0.5),
        "dsa_q_gain": gain(k[15], Dh),
        "dsa_k_gain": gain(k[16], Dh),
        "w_out": nrm(k[17], (L, MIX_WIDTH, D_MODEL), MIX_WIDTH ** -0.5),
    }


def reference(x, norm_gain, w_in, nsa_q_gain, nsa_kc_gain, nsa_ks_gain, nsa_kw_gain,
              cmp_pe_k, cmp_k_w1, cmp_k_b1, cmp_k_w2, cmp_pe_v, cmp_v_w1, cmp_v_b1, cmp_v_w2,
              dsa_q_gain, dsa_k_gain, w_out):
    for l in range(DEPTH):
        x = hybrid_layer(x, norm_gain[l], w_in[l], nsa_q_gain[l], nsa_kc_gain[l], nsa_ks_gain[l],
                         nsa_kw_gain[l], cmp_pe_k[l], cmp_k_w1[l], cmp_k_b1[l], cmp_k_w2[l],
                         cmp_pe_v[l], cmp_v_w1[l], cmp_v_b1[l], cmp_v_w2[l],
                         dsa_q_gain[l], dsa_k_gain[l], w_out[l])
    return x
```

```cpp
#include <hip/hip_runtime.h>
#include <hip/hip_cooperative_groups.h>
#include <stdint.h>
#include <cstdio>
namespace cg = cooperative_groups;

#ifndef COOP
#define COOP 0
#endif

typedef unsigned short bf16_t;
typedef short bf16x8 __attribute__((ext_vector_type(8)));
typedef float f32x4 __attribute__((ext_vector_type(4)));
typedef unsigned long long u64;

#define MFMA(a, b, c) __builtin_amdgcn_mfma_f32_16x16x32_bf16(a, b, c, 0, 0, 0)

constexpr int SEQ = 4096, DM = 1024, MROWS = 16384, NP = 3456, INC = 3420;
constexpr int C_QN = 0, C_KC = 512, C_VC = 640, C_KS = 768, C_KW = 1024, C_ZN = 1280, C_QD = 1792, C_KD = 2304,
              C_QI = 2560, C_KI = 2816, C_ZD = 2880;
constexpr float LOG2E = 1.4426950408889634f;
constexpr int SMEM_BYTES = 73728;

struct Params {
    const float *x, *norm_gain, *w_in, *nsa_q_gain, *nsa_kc_gain, *nsa_ks_gain, *nsa_kw_gain, *cmp_pe_k, *cmp_k_w1,
        *cmp_k_b1, *cmp_k_w2, *cmp_pe_v, *cmp_v_w1, *cmp_v_b1, *cmp_v_w2, *dsa_q_gain, *dsa_k_gain, *w_out;
    float* out;
    bf16_t *h, *WinT, *WoutT, *W1kT, *W1vT, *W2kT, *W2vT, *P, *VT, *KCc, *VCcT, *MIX;
    float *ropec, *ropes, *G, *WI;
    u64* MASK;
};

__device__ __forceinline__ unsigned cvt_pk_bf16(float lo, float hi) {
    unsigned r;
    asm("v_cvt_pk_bf16_f32 %0, %1, %2" : "=v"(r) : "v"(lo), "v"(hi));
    return r;
}
__device__ __forceinline__ bf16_t f2bf(float f) { return (bf16_t)(cvt_pk_bf16(f, 0.f) & 0xffff); }
__device__ __forceinline__ float bf2f(bf16_t h) { return __uint_as_float(((unsigned)h) << 16); }
__device__ __forceinline__ float fast_exp2(float x) { return __builtin_amdgcn_exp2f(x); }
__device__ __forceinline__ float sigmoidf_(float v) { return 1.f / (1.f + __expf(-v)); }

__device__ __forceinline__ int colmap(int c) {
    if (c < 1280) return c;
    if (c < 2880) return c + 24;
    if (c < 3392) return c + 28;
    if (c < 3416) return 1280 + (c - 3392);
    if (c < 3420) return 2904 + (c - 3416);
    return -1;
}

__device__ __forceinline__ void transpose_tile(const float* __restrict__ src, int ldsrc, bf16_t* __restrict__ dst, int K,
                                               int k0, int n0, bool mapped, float* lds) {
    const int tid = threadIdx.x;
    for (int e = tid; e < 4096; e += 256) {
        int r = e >> 6, c = e & 63;
        int oc = mapped ? colmap(n0 + c) : (n0 + c);
        lds[r * 65 + c] = (oc >= 0) ? src[(size_t)(k0 + r) * ldsrc + oc] : 0.f;
    }
    __syncthreads();
    {
        int n = tid >> 2, kk = (tid & 3) * 16;
        unsigned pk[8];
#pragma unroll
        for (int i = 0; i < 8; ++i) pk[i] = cvt_pk_bf16(lds[(kk + 2 * i) * 65 + n], lds[(kk + 2 * i + 1) * 65 + n]);
        uint4* d = (uint4*)(dst + (size_t)(n0 + n) * K + k0 + kk);
        d[0] = make_uint4(pk[0], pk[1], pk[2], pk[3]);
        d[1] = make_uint4(pk[4], pk[5], pk[6], pk[7]);
    }
    __syncthreads();
}

__device__ void phase0(const Params& p, char* smem, int bid, int nb) {
    const int tid = threadIdx.x, lane = tid & 63, w = tid >> 6;
    float* lds = (float*)smem;
    constexpr int N_RMS = 4096, N_TR = 864 + 256 + 128 + 128 + 4 + 4, N_ROPE = 512;
    constexpr int TOTAL = N_RMS + N_TR + N_ROPE + 1;
    for (int it = bid; it < TOTAL; it += nb) {
        if (it < N_RMS) {
            int row = it * 4 + w;
            const float4* xr = (const float4*)(p.x + (size_t)row * DM);
            float4 v[4];
            float ss = 0.f;
#pragma unroll
            for (int i = 0; i < 4; ++i) {
                v[i] = xr[lane + 64 * i];
                ss += v[i].x * v[i].x + v[i].y * v[i].y + v[i].z * v[i].z + v[i].w * v[i].w;
            }
#pragma unroll
            for (int m = 32; m >= 1; m >>= 1) ss += __shfl_xor(ss, m);
            float rstd = rsqrtf(ss * (1.f / DM) + 1e-6f);
#pragma unroll
            for (int i = 0; i < 4; ++i) {
                float4 g = ((const float4*)p.norm_gain)[lane + 64 * i];
                uint2 o;
                o.x = cvt_pk_bf16(v[i].x * rstd * g.x, v[i].y * rstd * g.y);
                o.y = cvt_pk_bf16(v[i].z * rstd * g.z, v[i].w * rstd * g.w);
                *(uint2*)(p.h + (size_t)row * DM + (lane + 64 * i) * 4) = o;
            }
        } else if (it < N_RMS + N_TR) {
            int i = it - N_RMS;
            if (i < 864) {
                transpose_tile(p.w_in, INC, p.WinT, 1024, (i / 54) * 64, (i % 54) * 64, true, lds);
            } else if ((i -= 864) < 256) {
                transpose_tile(p.w_out, 1024, p.WoutT, 1024, (i / 16) * 64, (i % 16) * 64, false, lds);
            } else if ((i -= 256) < 128) {
                transpose_tile(p.cmp_k_w1, 256, p.W1kT, 2048, (i / 4) * 64, (i % 4) * 64, false, lds);
            } else if ((i -= 128) < 128) {
                transpose_tile(p.cmp_v_w1, 256, p.W1vT, 2048, (i / 4) * 64, (i % 4) * 64, false, lds);
            } else if ((i -= 128) < 4) {
                transpose_tile(p.cmp_k_w2, 64, p.W2kT, 256, i * 64, 0, false, lds);
            } else {
                i -= 4;
                transpose_tile(p.cmp_v_w2, 64, p.W2vT, 256, i * 64, 0, false, lds);
            }
        } else if (it < N_RMS + N_TR + N_ROPE) {
            int e = (it - N_RMS - N_TR) * 256 + tid;
            int t = e >> 5, d = e & 31;
            float inv = powf(10000.f, -(float)d / 32.f);
            float ang = (float)t * inv;
            p.ropec[e] = cosf(ang);
            p.ropes[e] = sinf(ang);
        } else {
            for (int e = tid; e < 512; e += 256) {
                int bg = e >> 6, d = e & 63;
                p.KCc[((size_t)bg * 256 + 255) * 64 + d] = 0;
                p.VCcT[((size_t)bg * 64 + d) * 256 + 255] = 0;
            }
        }
    }
}

template <int EPI>
__device__ __forceinline__ void gemm_tile(const bf16_t* __restrict__ A, const bf16_t* __restrict__ Bt, int m0, int n0,
                                          char* smem, const Params& p) {
    constexpr int K = 1024, KT = K / 64, LR = 72;
    bf16_t* As = (bf16_t*)smem;
    bf16_t* Bs = As + 2 * 128 * LR;
    const int tid = threadIdx.x, lane = tid & 63, w = tid >> 6, wr = w >> 1, wc = w & 1, l = lane & 15, quad = lane >> 4;
    f32x4 acc[4][4];
#pragma unroll
    for (int i = 0; i < 4; ++i)
#pragma unroll
        for (int j = 0; j < 4; ++j) acc[i][j] = (f32x4){0.f, 0.f, 0.f, 0.f};
    const int srow = tid >> 3, scol = (tid & 7) * 8;
    const bf16_t* ga = A + (size_t)(m0 + srow) * K + scol;
    const bf16_t* gb = Bt + (size_t)(n0 + srow) * K + scol;
    bf16x8 ra[4], rb[4];
#pragma unroll
    for (int i = 0; i < 4; ++i) {
        ra[i] = *(const bf16x8*)(ga + (size_t)i * 32 * K);
        rb[i] = *(const bf16x8*)(gb + (size_t)i * 32 * K);
    }
#pragma unroll
    for (int i = 0; i < 4; ++i) {
        *(bf16x8*)(As + (srow + 32 * i) * LR + scol) = ra[i];
        *(bf16x8*)(Bs + (srow + 32 * i) * LR + scol) = rb[i];
    }
    __syncthreads();
    for (int kt = 0; kt < KT; ++kt) {
        const int cur = kt & 1;
        if (kt + 1 < KT) {
#pragma unroll
            for (int i = 0; i < 4; ++i) {
                ra[i] = *(const bf16x8*)(ga + (size_t)i * 32 * K + (kt + 1) * 64);
                rb[i] = *(const bf16x8*)(gb + (size_t)i * 32 * K + (kt + 1) * 64);
            }
        }
        const bf16_t* Ab = As + cur * 128 * LR + (wr * 64 + l) * LR + quad * 8;
        const bf16_t* Bb = Bs + cur * 128 * LR + (wc * 64 + l) * LR + quad * 8;
#pragma unroll
        for (int ks = 0; ks < 2; ++ks) {
            bf16x8 af[4], bfr[4];
#pragma unroll
            for (int i = 0; i < 4; ++i) {
                af[i] = *(const bf16x8*)(Ab + i * 16 * LR + ks * 32);
                bfr[i] = *(const bf16x8*)(Bb + i * 16 * LR + ks * 32);
            }
#pragma unroll
            for (int i = 0; i < 4; ++i)
#pragma unroll
                for (int j = 0; j < 4; ++j) acc[i][j] = MFMA(af[i], bfr[j], acc[i][j]);
        }
        if (kt + 1 < KT) {
            const int nx = cur ^ 1;
#pragma unroll
            for (int i = 0; i < 4; ++i) {
                *(bf16x8*)(As + nx * 128 * LR + (srow + 32 * i) * LR + scol) = ra[i];
                *(bf16x8*)(Bs + nx * 128 * LR + (srow + 32 * i) * LR + scol) = rb[i];
            }
        }
        __syncthreads();
    }
    if (EPI == 1) {
#pragma unroll
        for (int mi = 0; mi < 4; ++mi)
#pragma unroll
            for (int r = 0; r < 4; ++r) {
                size_t row = (size_t)m0 + wr * 64 + mi * 16 + quad * 4 + r;
#pragma unroll
                for (int ni = 0; ni < 4; ++ni) {
                    size_t idx = row * DM + n0 + wc * 64 + ni * 16 + l;
                    p.out[idx] = p.x[idx] + acc[mi][ni][r];
                }
            }
        return;
    }
    const int gidx = (n0 >> 6) + wc;
    int type = 0, vtw = 0;
    float scale = 1.f;
    const float* gain = nullptr;
    if (gidx < 8) { type = 1; gain = p.nsa_q_gain; scale = 0.125f; }
    else if (gidx < 12) { type = 0; }
    else if (gidx < 14) { type = 1; gain = p.nsa_ks_gain; }
    else if (gidx < 16) { type = 3; vtw = 0; }
    else if (gidx < 18) { type = 1; gain = p.nsa_kw_gain; }
    else if (gidx < 20) { type = 3; vtw = 1; }
    else if (gidx < 28) { type = 4; }
    else if (gidx < 36) { type = 1; gain = p.dsa_q_gain; scale = 0.125f; }
    else if (gidx < 38) { type = 1; gain = p.dsa_k_gain; }
    else if (gidx < 40) { type = 3; vtw = 2; }
    else if (gidx < 44) { type = 2; scale = 0.125f; }
    else if (gidx < 45) { type = 2; }
    else if (gidx < 53) { type = 4; }
    else { type = 5; }

    if (type == 3) {
        const int g = gidx & 1;
#pragma unroll
        for (int mi = 0; mi < 4; ++mi) {
            int row = m0 + wr * 64 + mi * 16 + quad * 4;
            int b = row >> 12, t = row & 4095;
#pragma unroll
            for (int ni = 0; ni < 4; ++ni) {
                int dim = ni * 16 + l;
                uint2 o;
                o.x = cvt_pk_bf16(acc[mi][ni][0], acc[mi][ni][1]);
                o.y = cvt_pk_bf16(acc[mi][ni][2], acc[mi][ni][3]);
                *(uint2*)(p.VT + ((((size_t)vtw * 4 + b) * 2 + g) * 64 + dim) * SEQ + t) = o;
            }
        }
        return;
    }
    float gn[4] = {1.f, 1.f, 1.f, 1.f};
    if (type == 1) {
#pragma unroll
        for (int ni = 0; ni < 4; ++ni) gn[ni] = gain[ni * 16 + l];
    }
#pragma unroll
    for (int mi = 0; mi < 4; ++mi)
#pragma unroll
        for (int r = 0; r < 4; ++r) {
            const int row = m0 + wr * 64 + mi * 16 + quad * 4 + r;
            const int t = row & 4095;
            float v[4];
#pragma unroll
            for (int ni = 0; ni < 4; ++ni) v[ni] = acc[mi][ni][r];
            if (type == 5) {
#pragma unroll
                for (int ni = 0; ni < 2; ++ni) {
                    int d = ni * 16 + l;
                    if (d < 24) p.G[(size_t)row * 24 + d] = sigmoidf_(v[ni]);
                    else if (d < 28) p.WI[(size_t)row * 4 + (d - 24)] = v[ni] * 0.5f;
                }
                continue;
            }
            if (type == 1) {
                float ss = v[0] * v[0] + v[1] * v[1] + v[2] * v[2] + v[3] * v[3];
                ss += __shfl_xor(ss, 1);
                ss += __shfl_xor(ss, 2);
                ss += __shfl_xor(ss, 4);
                ss += __shfl_xor(ss, 8);
                float rstd = rsqrtf(ss * (1.f / 64.f) + 1e-6f);
#pragma unroll
                for (int ni = 0; ni < 4; ++ni) v[ni] = v[ni] * rstd * gn[ni];
            }
            if (type == 1 || type == 2) {
#pragma unroll
                for (int ni = 0; ni < 2; ++ni) {
                    float c = p.ropec[t * 32 + ni * 16 + l], s = p.ropes[t * 32 + ni * 16 + l];
                    float x1 = v[ni], x2 = v[ni + 2];
                    v[ni] = (x1 * c - x2 * s) * scale;
                    v[ni + 2] = (x2 * c + x1 * s) * scale;
                }
            }
            if (type == 4) {
#pragma unroll
                for (int ni = 0; ni < 4; ++ni) v[ni] = v[ni] * sigmoidf_(v[ni]);
            }
            bf16_t* o = p.P + (size_t)row * NP + gidx * 64 + l;
#pragma unroll
            for (int ni = 0; ni < 4; ++ni) o[ni * 16] = f2bf(v[ni]);
        }
}

__device__ void phase1(const Params& p, char* smem, int bid, int nb) {
    for (int tile = bid; tile < 128 * 27; tile += nb) gemm_tile<0>(p.h, p.WinT, (tile / 27) * 128, (tile % 27) * 128, smem, p);
}
__device__ void phase4(const Params& p, char* smem, int bid, int nb) {
    for (int tile = bid; tile < 128 * 8; tile += nb) gemm_tile<1>(p.MIX, p.WoutT, (tile / 8) * 128, (tile % 8) * 128, smem, p);
}

__device__ void compress_item(const Params& p, char* smem, int ci) {
    const int tid = threadIdx.x, lane = tid & 63, w = tid >> 6, l = lane & 15, quad = lane >> 4;
    const int kv = ci >> 7, rt = ci & 127, rho0 = rt * 16;
    const bf16_t* W1T = kv ? p.W1vT : p.W1kT;
    const bf16_t* W2T = kv ? p.W2vT : p.W2kT;
    const float* pe = kv ? p.cmp_pe_v : p.cmp_pe_k;
    const float* b1 = kv ? p.cmp_v_b1 : p.cmp_k_b1;
    bf16_t* hid = (bf16_t*)smem;
    float* outf = (float*)(smem + 16 * 264 * 2);
    int rho = rho0 + l;
    if (rho > 2039) rho = 2039;
    const int b = rho / 510, rem = rho % 510, c = rem >> 1, g = rem & 1;
    const bf16_t* arow = p.P + ((size_t)b * SEQ + c * 16) * NP + (kv ? C_VC : C_KC) + g * 64 + quad * 8;
    const bf16_t* brow = W1T + (size_t)(w * 64 + l) * 2048 + quad * 8;
    f32x4 acc[4];
#pragma unroll
    for (int i = 0; i < 4; ++i) acc[i] = (f32x4){0.f, 0.f, 0.f, 0.f};
    for (int ks = 0; ks < 64; ++ks) {
        const int lrow = ks >> 1, d0 = (ks & 1) * 32;
        bf16x8 raw = *(const bf16x8*)(arow + (size_t)lrow * NP + d0);
        const float4* pp = (const float4*)(pe + lrow * 64 + d0 + quad * 8);
        float4 p0 = pp[0], p1 = pp[1];
        union { bf16x8 v; unsigned u[4]; } a;
        a.u[0] = cvt_pk_bf16(bf2f((bf16_t)raw[0]) + p0.x, bf2f((bf16_t)raw[1]) + p0.y);
        a.u[1] = cvt_pk_bf16(bf2f((bf16_t)raw[2]) + p0.z, bf2f((bf16_t)raw[3]) + p0.w);
        a.u[2] = cvt_pk_bf16(bf2f((bf16_t)raw[4]) + p1.x, bf2f((bf16_t)raw[5]) + p1.y);
        a.u[3] = cvt_pk_bf16(bf2f((bf16_t)raw[6]) + p1.z, bf2f((bf16_t)raw[7]) + p1.w);
#pragma unroll
        for (int ni = 0; ni < 4; ++ni) {
            bf16x8 bb = *(const bf16x8*)(brow + (size_t)ni * 16 * 2048 + ks * 32);
            acc[ni] = MFMA(a.v, bb, acc[ni]);
        }
    }
#pragma unroll
    for (int ni = 0; ni < 4; ++ni) {
        int col = w * 64 + ni * 16 + l;
        float bias = b1[col];
#pragma unroll
        for (int r = 0; r < 4; ++r) {
            float v = acc[ni][r] + bias;
            v = v * sigmoidf_(v);
            hid[(quad * 4 + r) * 264 + col] = f2bf(v);
        }
    }
    __syncthreads();
    {
        f32x4 a2 = (f32x4){0.f, 0.f, 0.f, 0.f};
#pragma unroll
        for (int ks = 0; ks < 8; ++ks) {
            bf16x8 a = *(const bf16x8*)(hid + l * 264 + ks * 32 + quad * 8);
            bf16x8 bb = *(const bf16x8*)(W2T + (size_t)(w * 16 + l) * 256 + ks * 32 + quad * 8);
            a2 = MFMA(a, bb, a2);
        }
#pragma unroll
        for (int r = 0; r < 4; ++r) outf[(quad * 4 + r) * 64 + w * 16 + l] = a2[r];
    }
    __syncthreads();
    {
        const int row = tid >> 4, j = tid & 15;
        const int rr = rho0 + row;
        float v[4];
#pragma unroll
        for (int i = 0; i < 4; ++i) v[i] = outf[row * 64 + j + 16 * i];
        const int rb = (rr < 2040) ? rr : 2039;
        const int b2 = rb / 510, rem2 = rb % 510, c2 = rem2 >> 1, g2 = rem2 & 1;
        if (kv == 0) {
            float ss = v[0] * v[0] + v[1] * v[1] + v[2] * v[2] + v[3] * v[3];
            ss += __shfl_xor(ss, 1);
            ss += __shfl_xor(ss, 2);
            ss += __shfl_xor(ss, 4);
            ss += __shfl_xor(ss, 8);
            float rstd = rsqrtf(ss * (1.f / 64.f) + 1e-6f);
#pragma unroll
            for (int i = 0; i < 4; ++i) v[i] = v[i] * rstd * p.nsa_kc_gain[j + 16 * i];
            const int pos = c2 * 16 + 31;
#pragma unroll
            for (int i = 0; i < 2; ++i) {
                float cc = p.ropec[pos * 32 + j + 16 * i], s = p.ropes[pos * 32 + j + 16 * i];
                float x1 = v[i], x2 = v[i + 2];
                v[i] = x1 * cc - x2 * s;
                v[i + 2] = x2 * cc + x1 * s;
            }
            if (rr < 2040) {
#pragma unroll
                for (int i = 0; i < 4; ++i) p.KCc[(((size_t)b2 * 2 + g2) * 256 + c2) * 64 + j + 16 * i] = f2bf(v[i]);
            }
        } else {
            if (rr < 2040) {
#pragma unroll
                for (int i = 0; i < 4; ++i) p.VCcT[(((size_t)b2 * 2 + g2) * 64 + j + 16 * i) * 256 + c2] = f2bf(v[i]);
            }
        }
    }
    __syncthreads();
}

__device__ void indexer_item(const Params& p, char* smem, int u) {
    const int tid = threadIdx.x, lane = tid & 63, w = tid >> 6, l = lane & 15, quad = lane >> 4;
    const int b = u & 3, t0 = (1023 - (u >> 2)) * 4;
    const int t = t0 + w;
    u64* mrow = p.MASK + ((size_t)b * SEQ + t) * 64;
    if (t0 < 256) {
        int lo = lane * 64;
        u64 m = (t >= lo + 63) ? ~0ull : (t < lo ? 0ull : ((1ull << (t - lo + 1)) - 1ull));
        mrow[lane] = m;
        return;
    }
    float* sc = (float*)smem;
    const int ntile = (t0 + 3) / 16 + 1;
    {
        const bf16_t* qa = p.P + ((size_t)b * SEQ + t0 + (l >> 2)) * NP + C_QI + (l & 3) * 64 + quad * 8;
        const bf16x8 a0 = *(const bf16x8*)qa, a1 = *(const bf16x8*)(qa + 32);
        const float4 wq = *(const float4*)(p.WI + ((size_t)b * SEQ + t0 + quad) * 4);
        const bf16_t* kb = p.P + ((size_t)b * SEQ + l) * NP + C_KI + quad * 8;
        for (int T = w; T < ntile; T += 4) {
            const bf16_t* kr = kb + (size_t)T * 16 * NP;
            bf16x8 b0 = *(const bf16x8*)kr, b1 = *(const bf16x8*)(kr + 32);
            f32x4 s = (f32x4){0.f, 0.f, 0.f, 0.f};
            s = MFMA(a0, b0, s);
            s = MFMA(a1, b1, s);
            float v = fmaxf(s[0], 0.f) * wq.x + fmaxf(s[1], 0.f) * wq.y + fmaxf(s[2], 0.f) * wq.z + fmaxf(s[3], 0.f) * wq.w;
            sc[quad * 4096 + T * 16 + l] = v;
        }
    }
    __syncthreads();
    {
        const int nregs = (t >> 6) + 1;
        unsigned key[64];
#pragma unroll
        for (int i = 0; i < 64; ++i) {
            unsigned kk = 0;
            if (i < nregs) {
                int kpos = i * 64 + lane;
                unsigned uu = __float_as_uint(sc[w * 4096 + kpos]);
                if (uu == 0x80000000u) uu = 0;
                uu ^= ((unsigned)((int)uu >> 31)) | 0x80000000u;
                kk = (kpos <= t) ? uu : 0u;
            }
            key[i] = kk;
        }
        unsigned Tt = 0;
        bool exact = false;
        for (int bit = 31; bit >= 0; --bit) {
            const unsigned cand = Tt | (1u << bit);
            int cnt = 0;
#pragma unroll
            for (int i = 0; i < 64; ++i)
                if (i < nregs) cnt += __popcll(__ballot(key[i] >= cand));
            if (cnt >= 256) {
                Tt = cand;
                if (cnt == 256) { exact = true; break; }
            }
        }
        int Jt = 4095;
        if (!exact) {
            int cgt = 0;
#pragma unroll
            for (int i = 0; i < 64; ++i)
                if (i < nregs) cgt += __popcll(__ballot(key[i] > Tt));
            const int need = 256 - cgt;
            Jt = 0;
            for (int bit = 11; bit >= 0; --bit) {
                const int cj = Jt | (1 << bit);
                int c = 0;
#pragma unroll
                for (int i = 0; i < 64; ++i)
                    if (i < nregs) c += __popcll(__ballot(key[i] == Tt && (i * 64 + lane) < cj));
                if (c < need) Jt = cj;
            }
        }
        u64 mine = 0;
#pragma unroll
        for (int i = 0; i < 64; ++i) {
            u64 m = 0;
            if (i < nregs) m = __ballot(key[i] > Tt || (key[i] == Tt && (i * 64 + lane) <= Jt));
            if (lane == i) mine = m;
        }
        mrow[lane] = mine;
    }
    __syncthreads();
}

__device__ void phase2(const Params& p, char* smem, int bid, int nb) {
    for (int it = bid; it < 256 + 4096; it += nb) {
        if (it < 256) compress_item(p, smem, it);
        else indexer_item(p, smem, it - 256);
    }
}

template <class MaskF, class HookF>
__device__ __forceinline__ void attn_block(const bf16_t* __restrict__ Kp, int kstride, const bf16_t* __restrict__ Vp,
                                           int vstride, const bf16x8 q0, const bf16x8 q1, f32x4 (&O)[4], float& lsum,
                                           bf16_t* plds, int l, int quad, MaskF mask, HookF hook) {
#pragma unroll
    for (int nt = 0; nt < 4; ++nt) {
        const bf16_t* kr = Kp + (size_t)(nt * 16 + l) * kstride + quad * 8;
        bf16x8 k0 = *(const bf16x8*)kr, k1 = *(const bf16x8*)(kr + 32);
        f32x4 s = (f32x4){0.f, 0.f, 0.f, 0.f};
        s = MFMA(k0, q0, s);
        s = MFMA(k1, q1, s);
        float pr[4];
#pragma unroll
        for (int r = 0; r < 4; ++r) {
            float e = fast_exp2(s[r] * LOG2E);
            pr[r] = mask(nt * 16 + quad * 4 + r) ? e : 0.f;
            lsum += pr[r];
        }
        hook(nt, pr);
        uint2 pk;
        pk.x = cvt_pk_bf16(pr[0], pr[1]);
        pk.y = cvt_pk_bf16(pr[2], pr[3]);
        *(uint2*)(plds + l * 72 + nt * 16 + quad * 4) = pk;
    }
#pragma unroll
    for (int kc = 0; kc < 2; ++kc) {
        bf16x8 pa = *(const bf16x8*)(plds + l * 72 + kc * 32 + quad * 8);
#pragma unroll
        for (int dt = 0; dt < 4; ++dt) {
            bf16x8 vb = *(const bf16x8*)(Vp + (size_t)(dt * 16 + l) * vstride + kc * 32 + quad * 8);
            O[dt] = MFMA(pa, vb, O[dt]);
        }
    }
}

__device__ __forceinline__ void accum_branch(f32x4 (&Otot)[4], f32x4 (&O)[4], float lsum, const float* gate, int quad) {
    lsum += __shfl_xor(lsum, 16);
    lsum += __shfl_xor(lsum, 32);
#pragma unroll
    for (int r = 0; r < 4; ++r) {
        float sr = __shfl(lsum, quad * 4 + r);
        float f = sr > 0.f ? gate[r] / sr : 0.f;
#pragma unroll
        for (int dt = 0; dt < 4; ++dt) Otot[dt][r] += O[dt][r] * f;
    }
}

__device__ __forceinline__ void zero4(f32x4 (&O)[4]) {
#pragma unroll
    for (int i = 0; i < 4; ++i) O[i] = (f32x4){0.f, 0.f, 0.f, 0.f};
}

__device__ void nsa_item(const Params& p, char* smem, int b, int g, int qt) {
    const int tid = threadIdx.x, lane = tid & 63, w = tid >> 6, l = lane & 15, quad = lane >> 4;
    bf16_t* plds = (bf16_t*)smem + w * (16 * 72);
    float* impq = (float*)(smem + 4 * 16 * 72 * 2) + w * (4 * 64);
    float* impb = (float*)(smem + 4 * 16 * 72 * 2 + 4 * 4 * 64 * 4) + w * (4 * 65);
    const int tw0 = qt * 16 + 4 * w;
    const int t_l = tw0 + (l >> 2);
    const int hl = l & 3;
    const int t_o = tw0 + quad;
    const int cur = tw0 >> 6;
    const size_t rowb = (size_t)b * SEQ;
    const bf16_t* qp = p.P + (rowb + t_l) * NP + C_QN + (g * 4 + hl) * 64 + quad * 8;
    const bf16x8 q0 = *(const bf16x8*)qp, q1 = *(const bf16x8*)(qp + 32);
    f32x4 Otot[4], O[4];
    zero4(Otot);
    float gate[4];
    const float* gp = p.G + (rowb + t_o) * 24 + g * 12;
    auto nohook = [](int, const float*) {};
    float impA[16], impB[16];
#pragma unroll
    for (int i = 0; i < 16; ++i) { impA[i] = 0.f; impB[i] = 0.f; }
    float lsum = 0.f;
    zero4(O);
    {
        const int tmax = tw0 + 3;
        const int nblk = (tmax >= 31) ? (((tmax - 31) >> 4) >> 6) + 1 : 0;
        const bf16_t* Kc = p.KCc + ((size_t)b * 2 + g) * 256 * 64;
        const bf16_t* Vc = p.VCcT + ((size_t)b * 2 + g) * 64 * 256;
#pragma unroll
        for (int blk = 0; blk < 4; ++blk) {
            if (blk < nblk) {
                attn_block(Kc + blk * 64 * 64, 64, Vc + blk * 64, 256, q0, q1, O, lsum, plds, l, quad,
                           [&](int key) { return (blk * 64 + key) * 16 + 31 <= t_l; },
                           [&](int nt, const float* pr) {
                               impA[blk * 4 + nt] = pr[0] + pr[1] + pr[2] + 0.5f * pr[3];
                               impB[blk * 4 + nt] = 0.5f * pr[3];
                           });
            }
        }
    }
#pragma unroll
    for (int r = 0; r < 4; ++r) gate[r] = gp[r * 3 + 0];
    float csum = lsum;
    csum += __shfl_xor(csum, 16);
    csum += __shfl_xor(csum, 32);
    accum_branch(Otot, O, lsum, gate, quad);
    {
        const float inv = csum > 0.f ? 1.f / csum : 0.f;
#pragma unroll
        for (int n = 0; n < 16; ++n) {
            float a = impA[n] * inv, bq = impB[n] * inv;
            a += __shfl_xor(a, 1);
            a += __shfl_xor(a, 2);
            bq += __shfl_xor(bq, 1);
            bq += __shfl_xor(bq, 2);
            if (hl == 0) {
                impq[(l >> 2) * 64 + n * 4 + quad] = a;
                impb[(l >> 2) * 65 + n * 4 + quad + 1] = bq;
            }
        }
    }
    u64 selm = 0, uni = 0;
#pragma unroll
    for (int q = 0; q < 4; ++q) {
        const int t = tw0 + q;
        const int j = lane;
        float v = impq[q * 64 + j] + (j > 0 ? impb[q * 65 + j] : 0.f);
        if (j == 0 || j == cur || j == cur - 1) v = 1e6f;
        if (j * 64 > t) v = -1e30f;
        int rank = 0;
#pragma unroll
        for (int i = 0; i < 64; ++i) {
            float vi = __int_as_float(__builtin_amdgcn_readlane(__float_as_int(v), i));
            rank += (vi > v || (vi == v && i < j)) ? 1 : 0;
        }
        u64 m = __ballot(rank < 16);
        uni |= m;
        if ((l >> 2) == q) selm = m;
    }
    lsum = 0.f;
    zero4(O);
    {
        const bf16_t* Ks = p.P + rowb * NP + C_KS + g * 64;
        const bf16_t* Vs = p.VT + (((size_t)0 * 4 + b) * 2 + g) * 64 * SEQ;
        for (int j = 0; j <= cur; ++j) {
            if (!((uni >> j) & 1ull)) continue;
            const bool mysel = (selm >> j) & 1ull;
            attn_block(Ks + (size_t)j * 64 * NP, NP, Vs + j * 64, SEQ, q0, q1, O, lsum, plds, l, quad,
                       [&](int key) { return mysel && (j * 64 + key <= t_l); }, nohook);
        }
    }
#pragma unroll
    for (int r = 0; r < 4; ++r) gate[r] = gp[r * 3 + 1];
    accum_branch(Otot, O, lsum, gate, quad);
    lsum = 0.f;
    zero4(O);
    {
        const bf16_t* Kw = p.P + rowb * NP + C_KW + g * 64;
        const bf16_t* Vw = p.VT + (((size_t)1 * 4 + b) * 2 + g) * 64 * SEQ;
        const int jlo = (tw0 >= 511) ? ((tw0 - 511) >> 6) : 0;
        for (int j = jlo; j <= cur; ++j) {
            attn_block(Kw + (size_t)j * 64 * NP, NP, Vw + j * 64, SEQ, q0, q1, O, lsum, plds, l, quad,
                       [&](int key) { int kp = j * 64 + key; return kp <= t_l && kp > t_l - 512; }, nohook);
        }
    }
#pragma unroll
    for (int r = 0; r < 4; ++r) gate[r] = gp[r * 3 + 2];
    accum_branch(Otot, O, lsum, gate, quad);
#pragma unroll
    for (int r = 0; r < 4; ++r) {
        const bf16_t* zp = p.P + (rowb + t_o) * NP + C_ZN + (g * 4 + r) * 64 + l;
        bf16_t* op = p.MIX + (rowb + t_o) * DM + (g * 4 + r) * 64 + l;
#pragma unroll
        for (int dt = 0; dt < 4; ++dt) op[dt * 16] = f2bf(Otot[dt][r] * bf2f(zp[dt * 16]));
    }
}

__device__ void dsa_item(const Params& p, char* smem, int b, int g, int qt) {
    const int tid = threadIdx.x, lane = tid & 63, w = tid >> 6, l = lane & 15, quad = lane >> 4;
    bf16_t* plds = (bf16_t*)smem + w * (16 * 72);
    const int tw0 = qt * 16 + 4 * w;
    const int t_l = tw0 + (l >> 2);
    const int hl = l & 3;
    const int t_o = tw0 + quad;
    const int cur = tw0 >> 6;
    const size_t rowb = (size_t)b * SEQ;
    const bf16_t* qp = p.P + (rowb + t_l) * NP + C_QD + (g * 4 + hl) * 64 + quad * 8;
    const bf16x8 q0 = *(const bf16x8*)qp, q1 = *(const bf16x8*)(qp + 32);
    f32x4 Otot[4], O[4];
    zero4(Otot);
    zero4(O);
    float lsum = 0.f;
    auto nohook = [](int, const float*) {};
    const bf16_t* Kd = p.P + rowb * NP + C_KD + g * 64;
    const bf16_t* Vd = p.VT + (((size_t)2 * 4 + b) * 2 + g) * 64 * SEQ;
    const u64* mp = p.MASK + (rowb + t_l) * 64;
    for (int j = 0; j <= cur; ++j) {
        const u64 mw = mp[j];
        attn_block(Kd + (size_t)j * 64 * NP, NP, Vd + j * 64, SEQ, q0, q1, O, lsum, plds, l, quad,
                   [&](int key) { return (bool)((mw >> key) & 1ull); }, nohook);
    }
    float gate[4] = {1.f, 1.f, 1.f, 1.f};
    accum_branch(Otot, O, lsum, gate, quad);
#pragma unroll
    for (int r = 0; r < 4; ++r) {
        const bf16_t* zp = p.P + (rowb + t_o) * NP + C_ZD + (g * 4 + r) * 64 + l;
        bf16_t* op = p.MIX + (rowb + t_o) * DM + 512 + (g * 4 + r) * 64 + l;
#pragma unroll
        for (int dt = 0; dt < 4; ++dt) op[dt * 16] = f2bf(Otot[dt][r] * bf2f(zp[dt * 16]));
    }
}

__device__ void phase3(const Params& p, char* smem, int bid, int nb) {
    for (int it = bid; it < 4096; it += nb) {
        const int pos = it >> 1, type = it & 1;
        const int qt = 255 - (pos >> 3), bg = pos & 7;
        if (type == 0) dsa_item(p, smem, bg >> 1, bg & 1, qt);
        else nsa_item(p, smem, bg >> 1, bg & 1, qt);
    }
}

#if COOP
__global__ void __launch_bounds__(256, 2) mega(Params p) {
    __shared__ __attribute__((aligned(16))) char smem[SMEM_BYTES];
    cg::grid_group grid = cg::this_grid();
    const int bid = blockIdx.x, nb = gridDim.x;
    phase0(p, smem, bid, nb);
    grid.sync();
    phase1(p, smem, bid, nb);
    grid.sync();
    phase2(p, smem, bid, nb);
    grid.sync();
    phase3(p, smem, bid, nb);
    grid.sync();
    phase4(p, smem, bid, nb);
}
#else
template <int PH>
__global__ void __launch_bounds__(256, 2) kphase(Params p) {
    __shared__ __attribute__((aligned(16))) char smem[SMEM_BYTES];
    const int bid = blockIdx.x, nb = gridDim.x;
    if (PH == 0) phase0(p, smem, bid, nb);
    if (PH == 1) phase1(p, smem, bid, nb);
    if (PH == 2) phase2(p, smem, bid, nb);
    if (PH == 3) phase3(p, smem, bid, nb);
    if (PH == 4) phase4(p, smem, bid, nb);
}
#endif

extern "C" void kernel_launch(void* const* d_in, const int* in_sizes, int n_in, void* d_out, int out_size, void* d_ws,
                              size_t ws_size, hipStream_t stream) {
    Params p{};
    const float** f = (const float**)&p;
    for (int i = 0; i < 18; ++i) f[i] = (const float*)d_in[i];
    p.out = (float*)d_out;
    char* ws = (char*)d_ws;
    size_t off = 0;
    auto take = [&](size_t bytes) { char* r = ws + off; off += (bytes + 255) & ~(size_t)255; return r; };
    p.h = (bf16_t*)take((size_t)MROWS * DM * 2);
    p.WinT = (bf16_t*)take((size_t)NP * 1024 * 2);
    p.WoutT = (bf16_t*)take((size_t)1024 * 1024 * 2);
    p.W1kT = (bf16_t*)take((size_t)256 * 2048 * 2);
    p.W1vT = (bf16_t*)take((size_t)256 * 2048 * 2);
    p.W2kT = (bf16_t*)take((size_t)64 * 256 * 2);
    p.W2vT = (bf16_t*)take((size_t)64 * 256 * 2);
    p.P = (bf16_t*)take((size_t)MROWS * NP * 2);
    p.VT = (bf16_t*)take((size_t)3 * 4 * 2 * 64 * SEQ * 2);
    p.KCc = (bf16_t*)take((size_t)8 * 256 * 64 * 2);
    p.VCcT = (bf16_t*)take((size_t)8 * 64 * 256 * 2);
    p.MIX = (bf16_t*)take((size_t)MROWS * DM * 2);
    p.ropec = (float*)take((size_t)SEQ * 32 * 4);
    p.ropes = (float*)take((size_t)SEQ * 32 * 4);
    p.G = (float*)take((size_t)MROWS * 24 * 4);
    p.WI = (float*)take((size_t)MROWS * 4 * 4);
    p.MASK = (u64*)take((size_t)MROWS * 64 * 8);
#if COOP
    static int grid_blocks = 0;
    if (!grid_blocks) {
        int dev = 0, cus = 0, per_cu = 0;
        hipGetDevice(&dev);
        hipDeviceGetAttribute(&cus, hipDeviceAttributeMultiprocessorCount, dev);
        hipOccupancyMaxActiveBlocksPerMultiprocessor(&per_cu, mega, 256, 0);
        if (per_cu > 2) per_cu = 2;
        grid_blocks = cus * per_cu;
    }
    void* args[] = {&p};
    hipError_t e = hipLaunchCooperativeKernel((void*)mega, dim3(grid_blocks), dim3(256), args, 0, stream);
    if (e != hipSuccess) fprintf(stderr, "cooperative launch failed: %s (grid %d)\n", hipGetErrorString(e), grid_blocks);
#else
    const int nb = 1024;
    kphase<0><<<nb, 256, 0, stream>>>(p);
    kphase<1><<<nb, 256, 0, stream>>>(p);
    kphase<2><<<nb, 256, 0, stream>>>(p);
    kphase<3><<<nb, 256, 0, stream>>>(p);
    kphase<4><<<nb, 256, 0, stream>>>(p);
#endif
}
```

```cpp
#include <hip/hip_runtime.h>
#include <hip/hip_cooperative_groups.h>
#include <stdint.h>
#include <cstdio>
#include <type_traits>
namespace cg = cooperative_groups;

#ifndef COOP
#define COOP 1
#endif

typedef unsigned short bf16_t;
typedef short bf16x8 __attribute__((ext_vector_type(8)));
typedef float f32x4 __attribute__((ext_vector_type(4)));
typedef unsigned long long u64;

#define MFMA(a, b, c) __builtin_amdgcn_mfma_f32_16x16x32_bf16(a, b, c, 0, 0, 0)

constexpr int SEQ = 4096, DM = 1024, MROWS = 16384, NP = 3456, INC = 3420;
constexpr int C_QN = 0, C_KC = 512, C_VC = 640, C_KS = 768, C_KW = 1024, C_ZN = 1280, C_QD = 1792, C_KD = 2304,
              C_QI = 2560, C_KI = 2816, C_ZD = 2880;
constexpr float LOG2E = 1.4426950408889634f;
constexpr int SMEM_BYTES = 73728;

struct Params {
    const float *x, *norm_gain, *w_in, *nsa_q_gain, *nsa_kc_gain, *nsa_ks_gain, *nsa_kw_gain, *cmp_pe_k, *cmp_k_w1,
        *cmp_k_b1, *cmp_k_w2, *cmp_pe_v, *cmp_v_w1, *cmp_v_b1, *cmp_v_w2, *dsa_q_gain, *dsa_k_gain, *w_out;
    float* out;
    bf16_t *h, *WinT, *WoutT, *W1kT, *W1vT, *W2kT, *W2vT, *P, *VT, *KCc, *VCcT, *MIX;
    float2* ropecs;
    float *G, *WI;
    u64* MASK;
    int* ctr;
    unsigned* bar;
};

__device__ __forceinline__ unsigned cvt_pk_bf16(float lo, float hi) {
    unsigned r;
    asm("v_cvt_pk_bf16_f32 %0, %1, %2" : "=v"(r) : "v"(lo), "v"(hi));
    return r;
}
__device__ __forceinline__ bf16_t f2bf(float f) { return (bf16_t)(cvt_pk_bf16(f, 0.f) & 0xffff); }
__device__ __forceinline__ float bf2f(bf16_t h) { return __uint_as_float(((unsigned)h) << 16); }
__device__ __forceinline__ float fast_exp2(float x) { return __builtin_amdgcn_exp2f(x); }
__device__ __forceinline__ float sigmoidf_(float v) { return __builtin_amdgcn_rcpf(1.f + fast_exp2(-v * LOG2E)); }

#define HM(gi, r) (p.P + ((size_t)(gi) * MROWS + (size_t)(r)) * 64)

__device__ __forceinline__ int colmap(int c) {
    if (c < 1280) return c;
    if (c < 2880) return c + 24;
    if (c < 3392) return c + 28;
    if (c < 3416) return 1280 + (c - 3392);
    if (c < 3420) return 2904 + (c - 3416);
    return -1;
}

__device__ __forceinline__ void transpose_tile(const float* __restrict__ src, int ldsrc, bf16_t* __restrict__ dst, int K,
                                               int k0, int n0, bool mapped, float* lds, bool frag = false) {
    const int tid = threadIdx.x;
    for (int e = tid; e < 4096; e += 256) {
        int r = e >> 6, c = e & 63;
        int oc = mapped ? colmap(n0 + c) : (n0 + c);
        lds[r * 65 + c] = (oc >= 0) ? src[(size_t)(k0 + r) * ldsrc + oc] : 0.f;
    }
    __syncthreads();
    {
        int n = tid >> 2, kk = (tid & 3) * 16;
        unsigned pk[8];
#pragma unroll
        for (int i = 0; i < 8; ++i) pk[i] = cvt_pk_bf16(lds[(kk + 2 * i) * 65 + n], lds[(kk + 2 * i + 1) * 65 + n]);
        if (frag) {
            const int ng = n0 + n;
#pragma unroll
            for (int c = 0; c < 2; ++c) {
                const int k = k0 + kk + 8 * c;
                uint4* d = (uint4*)(dst + ((((size_t)(ng >> 4) * (K >> 5) + (k >> 5)) * 64) + ((k >> 3) & 3) * 16 + (ng & 15)) * 8);
                *d = make_uint4(pk[4 * c], pk[4 * c + 1], pk[4 * c + 2], pk[4 * c + 3]);
            }
        } else {
            uint4* d = (uint4*)(dst + (size_t)(n0 + n) * K + k0 + kk);
            d[0] = make_uint4(pk[0], pk[1], pk[2], pk[3]);
            d[1] = make_uint4(pk[4], pk[5], pk[6], pk[7]);
        }
    }
    __syncthreads();
}

__device__ void phase0(const Params& p, char* smem, int bid, int nb) {
    const int tid = threadIdx.x, lane = tid & 63, w = __builtin_amdgcn_readfirstlane(tid >> 6);
    float* lds = (float*)smem;
    constexpr int N_RMS = 2048, N_TR = 864 + 256 + 128 + 128 + 4 + 4, N_ROPE = 512;
    constexpr int TOTAL = N_RMS + N_TR + N_ROPE + 1;
    for (int it = bid; it < TOTAL; it += nb) {
        if (it < N_RMS) {
            const int row0 = it * 8 + w * 2;
            float4 v[2][4];
            float ss[2] = {0.f, 0.f};
#pragma unroll
            for (int rr = 0; rr < 2; ++rr) {
                const float4* xr = (const float4*)(p.x + (size_t)(row0 + rr) * DM);
#pragma unroll
                for (int i = 0; i < 4; ++i) v[rr][i] = xr[lane + 64 * i];
            }
            float4 g[4];
#pragma unroll
            for (int i = 0; i < 4; ++i) g[i] = ((const float4*)p.norm_gain)[lane + 64 * i];
#pragma unroll
            for (int rr = 0; rr < 2; ++rr) {
#pragma unroll
                for (int i = 0; i < 4; ++i)
                    ss[rr] += v[rr][i].x * v[rr][i].x + v[rr][i].y * v[rr][i].y + v[rr][i].z * v[rr][i].z + v[rr][i].w * v[rr][i].w;
#pragma unroll
                for (int m = 32; m >= 1; m >>= 1) ss[rr] += __shfl_xor(ss[rr], m);
                const float rstd = rsqrtf(ss[rr] * (1.f / DM) + 1e-6f);
#pragma unroll
                for (int i = 0; i < 4; ++i) {
                    uint2 o;
                    o.x = cvt_pk_bf16(v[rr][i].x * rstd * g[i].x, v[rr][i].y * rstd * g[i].y);
                    o.y = cvt_pk_bf16(v[rr][i].z * rstd * g[i].z, v[rr][i].w * rstd * g[i].w);
                    *(uint2*)(p.h + (size_t)(row0 + rr) * DM + (lane + 64 * i) * 4) = o;
                }
            }
        } else if (it < N_RMS + N_TR) {
            int i = it - N_RMS;
            if (i < 864) {
                transpose_tile(p.w_in, INC, p.WinT, 1024, (i / 54) * 64, (i % 54) * 64, true, lds);
            } else if ((i -= 864) < 256) {
                transpose_tile(p.w_out, 1024, p.WoutT, 1024, (i / 16) * 64, (i % 16) * 64, false, lds);
            } else if ((i -= 256) < 128) {
                transpose_tile(p.cmp_k_w1, 256, p.W1kT, 2048, (i / 4) * 64, (i % 4) * 64, false, lds, true);
            } else if ((i -= 128) < 128) {
                transpose_tile(p.cmp_v_w1, 256, p.W1vT, 2048, (i / 4) * 64, (i % 4) * 64, false, lds, true);
            } else if ((i -= 128) < 4) {
                transpose_tile(p.cmp_k_w2, 64, p.W2kT, 256, i * 64, 0, false, lds);
            } else {
                i -= 4;
                transpose_tile(p.cmp_v_w2, 64, p.W2vT, 256, i * 64, 0, false, lds);
            }
        } else if (it < N_RMS + N_TR + N_ROPE) {
            int e = (it - N_RMS - N_TR) * 256 + tid;
            int t = e >> 5, d = e & 31;
            float inv = powf(10000.f, -(float)d / 32.f);
            float ang = (float)t * inv;
            p.ropecs[e] = make_float2(cosf(ang), sinf(ang));
        } else {
            for (int e = tid; e < 512; e += 256) {
                int bg = e >> 6, d = e & 63;
                p.KCc[((size_t)bg * 256 + 255) * 64 + d] = 0;
                p.VCcT[((size_t)bg * 64 + d) * 256 + 255] = 0;
            }
        }
    }
}

template <int EPI>
__device__ __forceinline__ void gemm_tile(const bf16_t* __restrict__ A, const bf16_t* __restrict__ Bt, int m0, int n0,
                                          char* smem, const Params& p) {
    constexpr int K = 1024, KT = K / 64, LR = 72;
    bf16_t* As = (bf16_t*)smem;
    bf16_t* Bs = As + 2 * 128 * LR;
    const int tid = threadIdx.x, lane = tid & 63, w = __builtin_amdgcn_readfirstlane(tid >> 6), wr = w >> 1, wc = w & 1, l = lane & 15, quad = lane >> 4;
    f32x4 acc[4][4];
#pragma unroll
    for (int i = 0; i < 4; ++i)
#pragma unroll
        for (int j = 0; j < 4; ++j) acc[i][j] = (f32x4){0.f, 0.f, 0.f, 0.f};
    const int srow = tid >> 3, scol = (tid & 7) * 8;
    const bf16_t* ga = A + (size_t)(m0 + srow) * K + scol;
    const bf16_t* gb = Bt + (size_t)(n0 + srow) * K + scol;
    bf16x8 ra[4], rb[4], rc[4], rd[4];
    auto ldt = [&](int kt, bf16x8 (&xa)[4], bf16x8 (&xb)[4]) {
#pragma unroll
        for (int i = 0; i < 4; ++i) {
            xa[i] = *(const bf16x8*)(ga + (size_t)i * 32 * K + kt * 64);
            xb[i] = *(const bf16x8*)(gb + (size_t)i * 32 * K + kt * 64);
        }
    };
    auto stt = [&](int buf, const bf16x8 (&xa)[4], const bf16x8 (&xb)[4]) {
#pragma unroll
        for (int i = 0; i < 4; ++i) {
            *(bf16x8*)(As + buf * 128 * LR + (srow + 32 * i) * LR + scol) = xa[i];
            *(bf16x8*)(Bs + buf * 128 * LR + (srow + 32 * i) * LR + scol) = xb[i];
        }
    };
    auto comp = [&](int cur) {
        const bf16_t* Ab = As + cur * 128 * LR + (wr * 64 + l) * LR + quad * 8;
        const bf16_t* Bb = Bs + cur * 128 * LR + (wc * 64 + l) * LR + quad * 8;
#pragma unroll
        for (int ks = 0; ks < 2; ++ks) {
            if (ks == 1) __builtin_amdgcn_sched_barrier(0);
            bf16x8 af[4], bfr[4];
#pragma unroll
            for (int i = 0; i < 4; ++i) {
                af[i] = *(const bf16x8*)(Ab + i * 16 * LR + ks * 32);
                bfr[i] = *(const bf16x8*)(Bb + i * 16 * LR + ks * 32);
            }
#pragma unroll
            for (int i = 0; i < 4; ++i)
#pragma unroll
                for (int j = 0; j < 4; ++j) acc[i][j] = MFMA(af[i], bfr[j], acc[i][j]);
        }
    };
    ldt(0, ra, rb);
    ldt(1, rc, rd);
    stt(0, ra, rb);
    __syncthreads();
#pragma unroll 1
    for (int kt = 0; kt < KT; kt += 2) {
        ldt(kt + 2 < KT ? kt + 2 : KT - 1, ra, rb);
        comp(0);
        stt(1, rc, rd);
        __syncthreads();
        ldt(kt + 3 < KT ? kt + 3 : KT - 1, rc, rd);
        comp(1);
        stt(0, ra, rb);
        __syncthreads();
    }
    if (EPI == 1) {
        float xv[4][4][4];
#pragma unroll
        for (int mi = 0; mi < 4; ++mi)
#pragma unroll
            for (int r = 0; r < 4; ++r)
#pragma unroll
                for (int ni = 0; ni < 4; ++ni)
                    xv[mi][r][ni] = p.x[((size_t)m0 + wr * 64 + mi * 16 + quad * 4 + r) * DM + n0 + wc * 64 + ni * 16 + l];
#pragma unroll
        for (int mi = 0; mi < 4; ++mi)
#pragma unroll
            for (int r = 0; r < 4; ++r)
#pragma unroll
                for (int ni = 0; ni < 4; ++ni)
                    p.out[((size_t)m0 + wr * 64 + mi * 16 + quad * 4 + r) * DM + n0 + wc * 64 + ni * 16 + l] = xv[mi][r][ni] + acc[mi][ni][r];
        return;
    }
    const int gidx = (n0 >> 6) + wc;
    int type = 0, vtw = 0;
    float scale = 1.f;
    const float* gain = nullptr;
    if (gidx < 8) { type = 1; gain = p.nsa_q_gain; scale = 0.125f * LOG2E; }
    else if (gidx < 12) { type = 0; }
    else if (gidx < 14) { type = 1; gain = p.nsa_ks_gain; }
    else if (gidx < 16) { type = 3; vtw = 0; }
    else if (gidx < 18) { type = 1; gain = p.nsa_kw_gain; }
    else if (gidx < 20) { type = 3; vtw = 1; }
    else if (gidx < 28) { type = 4; }
    else if (gidx < 36) { type = 1; gain = p.dsa_q_gain; scale = 0.125f * LOG2E; }
    else if (gidx < 38) { type = 1; gain = p.dsa_k_gain; }
    else if (gidx < 40) { type = 3; vtw = 2; }
    else if (gidx < 44) { type = 2; scale = 0.125f; }
    else if (gidx < 45) { type = 2; }
    else if (gidx < 53) { type = 4; }
    else { type = 5; }

    if (type == 3) {
        const int g = gidx & 1;
#pragma unroll
        for (int mi = 0; mi < 4; ++mi) {
            int row = m0 + wr * 64 + mi * 16 + quad * 4;
            int b = row >> 12, t = row & 4095;
#pragma unroll
            for (int ni = 0; ni < 4; ++ni) {
                int dim = ni * 16 + l;
                uint2 o;
                o.x = cvt_pk_bf16(acc[mi][ni][0], acc[mi][ni][1]);
                o.y = cvt_pk_bf16(acc[mi][ni][2], acc[mi][ni][3]);
                *(uint2*)(p.VT + ((((size_t)vtw * 4 + b) * 2 + g) * 64 + dim) * SEQ + t) = o;
            }
        }
        return;
    }
    float gn[4] = {1.f, 1.f, 1.f, 1.f};
    if (type == 1) {
#pragma unroll
        for (int ni = 0; ni < 4; ++ni) gn[ni] = gain[ni * 16 + l];
    }
    auto store_row = [&](int row, const float (&v)[4]) {
        if (gidx == 44) {
            bf16_t* o = HM(44, 0) + (size_t)(row >> 4) * 1024 + (row & 15) * 8 + (l & 7);
#pragma unroll
            for (int ni = 0; ni < 4; ++ni) o[(ni >> 1) * 512 + ((ni & 1) * 2 + (l >> 3)) * 128] = f2bf(v[ni]);
        } else {
            bf16_t* o = HM(gidx, row) + l;
#pragma unroll
            for (int ni = 0; ni < 4; ++ni) o[ni * 16] = f2bf(v[ni]);
        }
    };
    const int rowbase = m0 + wr * 64 + quad * 4;
    if (type == 5) {
#pragma unroll
        for (int mi = 0; mi < 4; ++mi)
#pragma unroll
            for (int r = 0; r < 4; ++r) {
                const int row = rowbase + mi * 16 + r;
#pragma unroll
                for (int ni = 0; ni < 2; ++ni) {
                    const int d = ni * 16 + l;
                    if (d < 24) p.G[(size_t)row * 24 + d] = sigmoidf_(acc[mi][ni][r]);
                    else if (d < 28) p.WI[(size_t)row * 4 + (d - 24)] = acc[mi][ni][r] * 0.5f;
                }
            }
    } else if (type == 1 || type == 2) {
        float2 cs[4][4][2];
#pragma unroll
        for (int mi = 0; mi < 4; ++mi)
#pragma unroll
            for (int r = 0; r < 4; ++r) {
                const int t = (rowbase + mi * 16 + r) & 4095;
#pragma unroll
                for (int ni = 0; ni < 2; ++ni) cs[mi][r][ni] = p.ropecs[t * 32 + ni * 16 + l];
            }
#pragma unroll
        for (int mi = 0; mi < 4; ++mi)
#pragma unroll
            for (int r = 0; r < 4; ++r) {
                float v[4];
#pragma unroll
                for (int ni = 0; ni < 4; ++ni) v[ni] = acc[mi][ni][r];
                if (type == 1) {
                    float ss = v[0] * v[0] + v[1] * v[1] + v[2] * v[2] + v[3] * v[3];
                    ss += __shfl_xor(ss, 1);
                    ss += __shfl_xor(ss, 2);
                    ss += __shfl_xor(ss, 4);
                    ss += __shfl_xor(ss, 8);
                    const float rstd = rsqrtf(ss * (1.f / 64.f) + 1e-6f);
#pragma unroll
                    for (int ni = 0; ni < 4; ++ni) v[ni] = v[ni] * rstd * gn[ni];
                }
#pragma unroll
                for (int ni = 0; ni < 2; ++ni) {
                    const float c = cs[mi][r][ni].x, sn = cs[mi][r][ni].y;
                    const float x1 = v[ni], x2 = v[ni + 2];
                    v[ni] = (x1 * c - x2 * sn) * scale;
                    v[ni + 2] = (x2 * c + x1 * sn) * scale;
                }
                store_row(rowbase + mi * 16 + r, v);
            }
    } else {
#pragma unroll
        for (int mi = 0; mi < 4; ++mi)
#pragma unroll
            for (int r = 0; r < 4; ++r) {
                float v[4];
#pragma unroll
                for (int ni = 0; ni < 4; ++ni) v[ni] = acc[mi][ni][r];
                if (type == 4) {
#pragma unroll
                    for (int ni = 0; ni < 4; ++ni) v[ni] = v[ni] * sigmoidf_(v[ni]);
                }
                store_row(rowbase + mi * 16 + r, v);
            }
    }
}

__device__ void phase1(const Params& p, char* smem, int* ctr);
__device__ void phase4(const Params& p, char* smem, int* ctr);


#define DEP_WORDS(p) ((unsigned*)((p).ctr + 1024))
__device__ __forceinline__ void dep_signal(unsigned* word, bool release_l2 = false) {
    asm volatile("s_waitcnt vmcnt(0)" ::: "memory");
    __syncthreads();
    if (threadIdx.x == 0) {
        if (release_l2) {
            __builtin_amdgcn_fence(__ATOMIC_RELEASE, "agent");
            asm volatile("s_waitcnt vmcnt(0)" ::: "memory");
        }
        __hip_atomic_fetch_add(word, 1u, __ATOMIC_RELAXED, __HIP_MEMORY_SCOPE_AGENT);
    }
}
#define DEP_IDX(p) (DEP_WORDS(p) + 128)
#define DEP_CMP(p) (DEP_WORDS(p) + 640)
__device__ __forceinline__ void dep_wait(unsigned* word, unsigned want) {
    if (threadIdx.x == 0) {
        unsigned spins = 0;
        while (__hip_atomic_load(word, __ATOMIC_RELAXED, __HIP_MEMORY_SCOPE_AGENT) < want) {
            __builtin_amdgcn_s_sleep(2);
            if (++spins > (1u << 21)) break;
        }
        __builtin_amdgcn_fence(__ATOMIC_ACQUIRE, "agent");
        asm volatile("s_waitcnt vmcnt(0)" ::: "memory");
    }
    __syncthreads();
}

__device__ void compress_item(const Params& p, char* smem, int ci) {
    const int tid = threadIdx.x, lane = tid & 63, w = __builtin_amdgcn_readfirstlane(tid >> 6), l = lane & 15, quad = lane >> 4;
    const int kv = ci >> 7, rt = ci & 127, rho0 = rt * 16;
    const bf16_t* W1T = kv ? p.W1vT : p.W1kT;
    const bf16_t* W2T = kv ? p.W2vT : p.W2kT;
    const float* pe = kv ? p.cmp_pe_v : p.cmp_pe_k;
    const float* b1 = kv ? p.cmp_v_b1 : p.cmp_k_b1;
    bf16_t* hid = (bf16_t*)smem;
    float* outf = (float*)(smem + 16 * 264 * 2);
    constexpr int ALD = 2056;
    bf16_t* As = (bf16_t*)smem;
#pragma unroll 4
    for (int i = 0; i < 16; ++i) {
        const int cidx = tid + 256 * i, row = cidx >> 8, k = (cidx & 255) * 8;
        int rho = rho0 + row;
        if (rho > 2039) rho = 2039;
        const int bb_ = rho / 510, rem = rho % 510, cc = rem >> 1, gg = rem & 1;
        const int lrow = k >> 6, d0 = k & 63;
        const bf16x8 raw = *(const bf16x8*)(HM((kv ? 10 : 8) + gg, (size_t)bb_ * SEQ + cc * 16 + lrow) + d0);
        const float4* pp = (const float4*)(pe + lrow * 64 + d0);
        const float4 p0 = pp[0], p1 = pp[1];
        union { bf16x8 v; unsigned u[4]; } a;
        a.u[0] = cvt_pk_bf16(bf2f((bf16_t)raw[0]) + p0.x, bf2f((bf16_t)raw[1]) + p0.y);
        a.u[1] = cvt_pk_bf16(bf2f((bf16_t)raw[2]) + p0.z, bf2f((bf16_t)raw[3]) + p0.w);
        a.u[2] = cvt_pk_bf16(bf2f((bf16_t)raw[4]) + p1.x, bf2f((bf16_t)raw[5]) + p1.y);
        a.u[3] = cvt_pk_bf16(bf2f((bf16_t)raw[6]) + p1.z, bf2f((bf16_t)raw[7]) + p1.w);
        *(bf16x8*)(As + row * ALD + k) = a.v;
    }
    const bf16_t* brow = W1T + (size_t)(w * 4) * 64 * 512 + lane * 8;
    f32x4 acc[4];
#pragma unroll
    for (int i = 0; i < 4; ++i) acc[i] = (f32x4){0.f, 0.f, 0.f, 0.f};
    {
        bf16x8 X[4], Y[4];
        auto bload = [&](int ks, bf16x8 (&st)[4]) {
#pragma unroll
            for (int ni = 0; ni < 4; ++ni) st[ni] = *(const bf16x8*)(brow + ((size_t)ni * 64 + ks) * 512);
        };
        bload(0, X);
        bload(1, Y);
        __syncthreads();
        const bf16_t* arow = As + l * ALD + quad * 8;
#pragma unroll 1
        for (int ks = 0; ks < 64; ks += 2) {
            const bf16x8 a0 = *(const bf16x8*)(arow + ks * 32), a1 = *(const bf16x8*)(arow + ks * 32 + 32);
#pragma unroll
            for (int ni = 0; ni < 4; ++ni) acc[ni] = MFMA(a0, X[ni], acc[ni]);
            bload(ks + 2 < 64 ? ks + 2 : 63, X);
#pragma unroll
            for (int ni = 0; ni < 4; ++ni) acc[ni] = MFMA(a1, Y[ni], acc[ni]);
            bload(ks + 3 < 64 ? ks + 3 : 63, Y);
        }
    }
    __syncthreads();
    float biasv[4];
#pragma unroll
    for (int ni = 0; ni < 4; ++ni) biasv[ni] = b1[w * 64 + ni * 16 + l];
#pragma unroll
    for (int ni = 0; ni < 4; ++ni) {
        int col = w * 64 + ni * 16 + l;
        float bias = biasv[ni];
#pragma unroll
        for (int r = 0; r < 4; ++r) {
            float v = acc[ni][r] + bias;
            v = v * sigmoidf_(v);
            hid[(quad * 4 + r) * 264 + col] = f2bf(v);
        }
    }
    __syncthreads();
    {
        f32x4 a2 = (f32x4){0.f, 0.f, 0.f, 0.f};
#pragma unroll
        for (int ks = 0; ks < 8; ++ks) {
            bf16x8 a = *(const bf16x8*)(hid + l * 264 + ks * 32 + quad * 8);
            bf16x8 bb = *(const bf16x8*)(W2T + (size_t)(w * 16 + l) * 256 + ks * 32 + quad * 8);
            a2 = MFMA(a, bb, a2);
        }
#pragma unroll
        for (int r = 0; r < 4; ++r) outf[(quad * 4 + r) * 64 + w * 16 + l] = a2[r];
    }
    __syncthreads();
    {
        const int row = tid >> 4, j = tid & 15;
        const int rr = rho0 + row;
        float v[4];
#pragma unroll
        for (int i = 0; i < 4; ++i) v[i] = outf[row * 64 + j + 16 * i];
        const int rb = (rr < 2040) ? rr : 2039;
        const int b2 = rb / 510, rem2 = rb % 510, c2 = rem2 >> 1, g2 = rem2 & 1;
        if (kv == 0) {
            float gk[4];
            float2 csk[2];
            const int posk = c2 * 16 + 31;
#pragma unroll
            for (int i = 0; i < 4; ++i) gk[i] = p.nsa_kc_gain[j + 16 * i];
#pragma unroll
            for (int i = 0; i < 2; ++i) csk[i] = p.ropecs[posk * 32 + j + 16 * i];
            float ss = v[0] * v[0] + v[1] * v[1] + v[2] * v[2] + v[3] * v[3];
            ss += __shfl_xor(ss, 1);
            ss += __shfl_xor(ss, 2);
            ss += __shfl_xor(ss, 4);
            ss += __shfl_xor(ss, 8);
            float rstd = rsqrtf(ss * (1.f / 64.f) + 1e-6f);
#pragma unroll
            for (int i = 0; i < 4; ++i) v[i] = v[i] * rstd * gk[i];
            const int pos = c2 * 16 + 31;
#pragma unroll
            for (int i = 0; i < 2; ++i) {
                const float2 csv = csk[i];
                float cc = csv.x, s = csv.y;
                float x1 = v[i], x2 = v[i + 2];
                v[i] = x1 * cc - x2 * s;
                v[i + 2] = x2 * cc + x1 * s;
            }
            if (rr < 2040) {
#pragma unroll
                for (int i = 0; i < 4; ++i) p.KCc[(((size_t)b2 * 2 + g2) * 256 + c2) * 64 + j + 16 * i] = f2bf(v[i]);
            }
        } else {
            if (rr < 2040) {
#pragma unroll
                for (int i = 0; i < 4; ++i) p.VCcT[(((size_t)b2 * 2 + g2) * 64 + j + 16 * i) * 256 + c2] = f2bf(v[i]);
            }
        }
    }
    dep_signal(DEP_CMP(p), true);
    __syncthreads();
}

__device__ void indexer_item(const Params& p, char* smem, int u) {
    const int tid = threadIdx.x, lane = tid & 63, w = __builtin_amdgcn_readfirstlane(tid >> 6), l = lane & 15, quad = lane >> 4;
    const int b = u & 3, t0 = (u >> 2) * 8;
    const size_t rowb = (size_t)b * SEQ;
    if (t0 < 256) {
#pragma unroll
        for (int h = 0; h < 2; ++h) {
            const int t = t0 + w + 4 * h;
            const int lo = lane * 64;
            const u64 m = (t >= lo + 63) ? ~0ull : (t < lo ? 0ull : ((1ull << (t - lo + 1)) - 1ull));
            __hip_atomic_store(&p.MASK[(rowb + t) * 64 + lane], m, __ATOMIC_RELAXED, __HIP_MEMORY_SCOPE_AGENT);
        }
        dep_signal(DEP_IDX(p) + b * 128 + (t0 >> 5));
        return;
    }
    unsigned short* sc = (unsigned short*)smem;
    const int ntile = (t0 + 7) / 16 + 1;
    {
        bf16x8 a[2][2];
        float4 wq[2];
#pragma unroll
        for (int rt = 0; rt < 2; ++rt) {
            const bf16_t* qa = HM(40 + (l & 3), rowb + t0 + 4 * rt + (l >> 2)) + quad * 8;
            a[rt][0] = *(const bf16x8*)qa;
            a[rt][1] = *(const bf16x8*)(qa + 32);
            wq[rt] = *(const float4*)(p.WI + (rowb + t0 + 4 * rt + quad) * 4);
        }
        const bf16_t* kb = HM(44, 0) + (rowb >> 4) * 1024 + lane * 8;
        constexpr int CH = 5;
        const int nmine = (ntile - w + 3) >> 2;
        const int nchunk = (nmine + CH - 1) / CH;
        auto loadc = [&](int c, bf16x8 (&r0)[CH], bf16x8 (&r1)[CH]) {
#pragma unroll
            for (int uu = 0; uu < CH; ++uu) {
                int i = c * CH + uu;
                i = i < nmine ? i : nmine - 1;
                i = i < 0 ? 0 : i;
                const bf16_t* kr = kb + (size_t)(w + 4 * i) * 1024;
                r0[uu] = *(const bf16x8*)kr;
                r1[uu] = *(const bf16x8*)(kr + 512);
            }
        };
        auto compc = [&](int c, const bf16x8 (&r0)[CH], const bf16x8 (&r1)[CH]) {
#pragma unroll
            for (int uu = 0; uu < CH; ++uu) {
                const int i = c * CH + uu;
                if (i < nmine) {
#pragma unroll
                    for (int rt = 0; rt < 2; ++rt) {
                        f32x4 s = (f32x4){0.f, 0.f, 0.f, 0.f};
                        s = MFMA(a[rt][0], r0[uu], s);
                        s = MFMA(a[rt][1], r1[uu], s);
                        const float v = fmaxf(s[0], 0.f) * wq[rt].x + fmaxf(s[1], 0.f) * wq[rt].y + fmaxf(s[2], 0.f) * wq[rt].z +
                                        fmaxf(s[3], 0.f) * wq[rt].w;
                        const _Float16 hv = (_Float16)v;
                        unsigned k = (unsigned)__builtin_bit_cast(unsigned short, hv);
                        if (k == 0x8000u) k = 0u;
                        k ^= (k & 0x8000u) ? 0xFFFFu : 0x8000u;
                        sc[(4 * rt + quad) * 4096 + (w + 4 * i) * 16 + l] = (unsigned short)k;
                    }
                }
            }
        };
        bf16x8 A0[CH], A1[CH], B0[CH], B1[CH];
        loadc(0, A0, A1);
        loadc(1, B0, B1);
        asm volatile("" ::"v"(a[0][0]), "v"(a[0][1]), "v"(a[1][0]), "v"(a[1][1]));
        asm volatile("" ::"v"(wq[0].x), "v"(wq[0].y), "v"(wq[0].z), "v"(wq[0].w), "v"(wq[1].x), "v"(wq[1].y), "v"(wq[1].z), "v"(wq[1].w));
#pragma unroll 1
        for (int c = 0; c < nchunk; c += 2) {
            compc(c, A0, A1);
            loadc(c + 2, A0, A1);
            compc(c + 1, B0, B1);
            loadc(c + 3, B0, B1);
        }
    }
    __syncthreads();
#pragma unroll 1
    for (int h = 0; h < 2; ++h) {
        const int qq = w + 4 * h, t = t0 + qq;
        const int nregs = (t >> 6) + 1;
        const int ngrp = (nregs + 7) >> 3;
        unsigned key[64];
#pragma unroll
        for (int i = 0; i < 64; ++i) {
            const int kpos = i * 64 + lane;
            const unsigned k16 = sc[qq * 4096 + kpos];
            key[i] = (kpos <= t) ? ((k16 << 12) | (unsigned)(4095 - kpos)) : 0u;
        }
        unsigned Tt = 0;
        for (int bit = 27; bit >= 0; --bit) {
            const unsigned cand = Tt | (1u << bit);
            int cnt = 0;
#pragma unroll
            for (int g = 0; g < 8; ++g) {
                if (g < ngrp) {
                    u64 bb[8];
#pragma unroll
                    for (int i = 0; i < 8; ++i)
                        asm("v_cmp_ge_u32_e64 %0, %1, %2" : "=s"(bb[i]) : "v"(key[g * 8 + i]), "v"(cand));
                    __builtin_amdgcn_sched_barrier(0);
#pragma unroll
                    for (int i = 0; i < 8; ++i) cnt += __builtin_popcountll(bb[i]);
                    __builtin_amdgcn_sched_barrier(0);
                }
            }
            if (cnt >= 256) {
                Tt = cand;
                if (cnt == 256) break;
            }
        }
        u64 mine = 0;
#pragma unroll
        for (int i = 0; i < 64; ++i) {
            const u64 m = __ballot(key[i] >= Tt && Tt != 0u);
            if (lane == i) mine = m;
        }
        __hip_atomic_store(&p.MASK[(rowb + t) * 64 + lane], mine, __ATOMIC_RELAXED, __HIP_MEMORY_SCOPE_AGENT);
    }
    dep_signal(DEP_IDX(p) + b * 128 + (t0 >> 5));
    __syncthreads();
}

__device__ __forceinline__ unsigned hw_xcc_id() { return (unsigned)__builtin_amdgcn_s_getreg((3 << 11) | 20) & 0xFu; }

__device__ __forceinline__ int next_item_xcd(int* ctr, int* slot, int& q, int& tries, int qlen) {
    for (;;) {
        __syncthreads();
        if (threadIdx.x == 0) *slot = atomicAdd(ctr + q * 16, 1);
        __syncthreads();
        const int it = *slot;
        if (it < qlen) return it;
        if (++tries >= 8) return -1;
        q = (q + 1) & 7;
    }
}

__device__ void phase1(const Params& p, char* smem, int* ctr) {
    int* slot = (int*)(smem + SMEM_BYTES - 16);
    int q = hw_xcc_id() & 7, tries = 0;
    for (;;) {
        const int it = next_item_xcd(ctr, slot, q, tries, 432);
        if (it < 0) break;
        const int half = it / 216, r = it % 216;
        gemm_tile<0>(p.h, p.WinT, (q * 16 + half * 8 + (r & 7)) * 128, (r >> 3) * 128, smem, p);
    }
}
__device__ void phase4(const Params& p, char* smem, int* ctr) {
    int* slot = (int*)(smem + SMEM_BYTES - 16);
    int q = hw_xcc_id() & 7, tries = 0;
    for (;;) {
        const int it = next_item_xcd(ctr, slot, q, tries, 128);
        if (it < 0) break;
        const int rk = (it >> 3) * 8 + q;
        const int mt = (rk & 3) * 32 + 31 - (rk >> 2);
        dep_wait(DEP_WORDS(p) + mt, 16u);
        gemm_tile<1>(p.MIX, p.WoutT, mt * 128, (it & 7) * 128, smem, p);
    }
}

__device__ void phase2(const Params& p, char* smem, int* ctr) {
    int* slot = (int*)(smem + SMEM_BYTES - 16);
    int q = hw_xcc_id() & 7, tries = 0;
    for (;;) {
        const int it = next_item_xcd(ctr, slot, q, tries, 32 + 256);
        if (it < 0) break;
        if (it < 32) compress_item(p, smem, q * 32 + it);
        else {
            const int i = it - 32;
            const int oct = 511 - (2 * i + (q & 1));
            indexer_item(p, smem, (oct << 2) | (q >> 1));
        }
    }
}

constexpr int KV_LD = 72;
constexpr int KV_TILE = 64 * KV_LD;

template <int RT>
struct RangeMask {
    int t[RT];
    int hi[RT], lo[RT], m0[RT];
    u64 selm[RT];
    int mode;
    int tmin, tmax;
    static constexpr bool HAS_SIMPLE = true;
    __device__ __forceinline__ bool simple(int j) const {
        if (mode == 0) return (j * 64 + 63) * 16 + 31 <= tmin;
        if (mode == 1) return j * 64 + 63 <= tmin;
        return (j * 64 + 63 <= tmin) && (j * 64 > tmax - 512);
    }
    __device__ __forceinline__ int m0s(int rt) const { return m0[rt]; }
    __device__ __forceinline__ void ld(int) {}
    __device__ __forceinline__ void st(int) {}
    __device__ __forceinline__ void begin_tile(int j, int) {
#pragma unroll
        for (int rt = 0; rt < RT; ++rt) {
            if (mode == 0) { hi[rt] = ((t[rt] - 31) >> 4) - j * 64; lo[rt] = -1; m0[rt] = -1; }
            else if (mode == 1) { hi[rt] = t[rt] - j * 64; lo[rt] = -1; m0[rt] = -(int)((selm[rt] >> j) & 1ull); }
            else { hi[rt] = t[rt] - j * 64; lo[rt] = hi[rt] - 512; m0[rt] = -1; }
        }
    }
    __device__ __forceinline__ int mask(int rt, int key) const { return (key <= hi[rt] && key > lo[rt]) ? m0[rt] : 0; }
};

template <int RT>
struct BitMask {
    const u64* gsrc;
    u64* lds;
    int slot;
    int qidx[RT];
    u64 reg;
    unsigned lo[RT], hi[RT];
    int quad4;
    static constexpr bool HAS_SIMPLE = false;
    __device__ __forceinline__ bool simple(int) const { return false; }
    __device__ __forceinline__ int m0s(int) const { return -1; }
    __device__ __forceinline__ void ld(int j) { reg = gsrc[j]; }
    __device__ __forceinline__ void st(int buf) { lds[buf * 32 + slot] = reg; }
    __device__ __forceinline__ void begin_tile(int, int buf) {
#pragma unroll
        for (int rt = 0; rt < RT; ++rt) {
            const u64 wv = lds[buf * 32 + qidx[rt]];
            lo[rt] = ((unsigned)wv) >> quad4;
            hi[rt] = ((unsigned)(wv >> 32)) >> quad4;
        }
    }
    __device__ __forceinline__ int mask(int rt, int key) const {
        const unsigned wv = (key & 32) ? hi[rt] : lo[rt];
        const int sh = (key & 31) - quad4;
        int m = __builtin_amdgcn_sbfe((int)wv, sh, 1);
        asm("" : "+v"(m));
        return m;
    }
};

template <int RT, bool DO_PV, bool HOOK, bool HAS_OFF, bool SIMPLE, class F, class H>
__device__ __forceinline__ void attn_tiles(const bf16_t* __restrict__ Kg, int kstride, const bf16_t* __restrict__ Vg, int vstride,
                                           int jb, int je, const bf16x8 (&qf)[RT][2], f32x4 (&OT)[RT][4], float (&lsum)[RT],
                                           const float (&off)[RT], bf16_t* Ks, bf16_t* Vs, F& f, H hook) {
    const int tid = threadIdx.x, lane = tid & 63, l = lane & 15, quad = lane >> 4;
    const int srow = tid >> 3, scol = (tid & 7) * 8;
    if (jb > je) return;
    bf16x8 rk[2], rv[2];
    const bf16_t* kg = Kg + (size_t)srow * kstride + scol;
    const bf16_t* vg = Vg + (size_t)srow * vstride + scol;
#pragma unroll
    for (int i = 0; i < 2; ++i) {
        rk[i] = *(const bf16x8*)(kg + (size_t)(jb * 64 + 32 * i) * kstride);
        rv[i] = *(const bf16x8*)(vg + (size_t)(32 * i) * vstride + jb * 64);
    }
    f.ld(jb);
#pragma unroll
    for (int rt = 0; rt < RT; ++rt) asm volatile("" ::"v"(qf[rt][0]), "v"(qf[rt][1]));
#pragma unroll
    for (int i = 0; i < 2; ++i) {
        *(bf16x8*)(Ks + (srow + 32 * i) * KV_LD + scol) = rk[i];
        *(bf16x8*)(Vs + (srow + 32 * i) * KV_LD + scol) = rv[i];
    }
    f.st(0);
    {
        const int jn = jb < je ? jb + 1 : je;
#pragma unroll
        for (int i = 0; i < 2; ++i) {
            rk[i] = *(const bf16x8*)(kg + (size_t)(jn * 64 + 32 * i) * kstride);
            rv[i] = *(const bf16x8*)(vg + (size_t)(32 * i) * vstride + jn * 64);
        }
        f.ld(jn);
    }
    __syncthreads();
#pragma unroll 1
    for (int j = jb; j <= je; ++j) {
        const int cur = (j - jb) & 1;
        {
            const int nx = cur ^ 1;
#pragma unroll
            for (int i = 0; i < 2; ++i) {
                *(bf16x8*)(Ks + nx * KV_TILE + (srow + 32 * i) * KV_LD + scol) = rk[i];
                *(bf16x8*)(Vs + nx * KV_TILE + (srow + 32 * i) * KV_LD + scol) = rv[i];
            }
            f.st(nx);
            const int jn = j + 2 <= je ? j + 2 : je;
#pragma unroll
            for (int i = 0; i < 2; ++i) {
                rk[i] = *(const bf16x8*)(kg + (size_t)(jn * 64 + 32 * i) * kstride);
                rv[i] = *(const bf16x8*)(vg + (size_t)(32 * i) * vstride + jn * 64);
            }
            f.ld(jn);
        }
        f.begin_tile(j, cur);
        {
        const bf16_t* Kb = Ks + cur * KV_TILE + l * KV_LD + quad * 8;
        const bf16_t* Vb = Vs + cur * KV_TILE + l * KV_LD + quad * 4;
#pragma unroll
        for (int np = 0; np < 2; ++np) {
            f32x4 S[RT][2];
#pragma unroll
            for (int n2 = 0; n2 < 2; ++n2) {
                const int nt = np * 2 + n2;
                const bf16x8 k0 = *(const bf16x8*)(Kb + nt * 16 * KV_LD), k1 = *(const bf16x8*)(Kb + nt * 16 * KV_LD + 32);
#pragma unroll
                for (int rt = 0; rt < RT; ++rt) {
                    f32x4 s = (f32x4){0.f, 0.f, 0.f, 0.f};
                    s = MFMA(k0, qf[rt][0], s);
                    S[rt][n2] = MFMA(k1, qf[rt][1], s);
                }
            }
            bf16x8 pb[RT];
#pragma unroll
            for (int rt = 0; rt < RT; ++rt) {
                float pr[8];
#pragma unroll
                for (int n2 = 0; n2 < 2; ++n2)
#pragma unroll
                    for (int r = 0; r < 4; ++r) {
                        const float e = fast_exp2(HAS_OFF ? S[rt][n2][r] + off[rt] : S[rt][n2][r]);
                        const int m = SIMPLE ? f.m0s(rt) : f.mask(rt, (np * 2 + n2) * 16 + quad * 4 + r);
                        const float pv = __int_as_float(__float_as_int(e) & m);
                        pr[n2 * 4 + r] = pv;
                        lsum[rt] += pv;
                    }
                if (HOOK) {
                    hook(rt, j, np * 2, &pr[0]);
                    hook(rt, j, np * 2 + 1, &pr[4]);
                }
                union { bf16x8 v; unsigned u[4]; } pk;
                pk.u[0] = cvt_pk_bf16(pr[0], pr[1]);
                pk.u[1] = cvt_pk_bf16(pr[2], pr[3]);
                pk.u[2] = cvt_pk_bf16(pr[4], pr[5]);
                pk.u[3] = cvt_pk_bf16(pr[6], pr[7]);
                pb[rt] = pk.v;
            }
            if (DO_PV) {
#pragma unroll
                for (int dt = 0; dt < 4; ++dt) {
                    union { bf16x8 v; uint2 h[2]; } va;
                    va.h[0] = *(const uint2*)(Vb + dt * 16 * KV_LD + (np * 2) * 16);
                    va.h[1] = *(const uint2*)(Vb + dt * 16 * KV_LD + (np * 2 + 1) * 16);
#pragma unroll
                    for (int rt = 0; rt < RT; ++rt) OT[rt][dt] = MFMA(va.v, pb[rt], OT[rt][dt]);
                }
            }
        }
        }
        __syncthreads();
    }
}

template <int RT>
__device__ __forceinline__ void zeroOT(f32x4 (&O)[RT][4]) {
#pragma unroll
    for (int a = 0; a < RT; ++a)
#pragma unroll
        for (int i = 0; i < 4; ++i) O[a][i] = (f32x4){0.f, 0.f, 0.f, 0.f};
}
__device__ __forceinline__ float quadsum(float v) {
    v += __shfl_xor(v, 16);
    v += __shfl_xor(v, 32);
    return v;
}

__device__ void nsa_item(const Params& p, char* smem, int b, int g, int qt32) {
    constexpr int RT = 2;
    dep_wait(DEP_CMP(p), 256u);
    const int tid = threadIdx.x, lane = tid & 63, w = __builtin_amdgcn_readfirstlane(tid >> 6), l = lane & 15, quad = lane >> 4;
    bf16_t* Ks = (bf16_t*)smem;
    bf16_t* Vs = Ks + 2 * KV_TILE;
    float* impq = (float*)(smem + 4 * KV_TILE * 2) + w * (8 * 64 + 8 * 65);
    float* impb = impq + 8 * 64;
    const int t0b = qt32 * 32, tw0 = t0b + 8 * w;
    const int hl = l & 3;
    const int cur = t0b >> 6;
    const size_t rowb = (size_t)b * SEQ;
    int tq[RT];
    bf16x8 qf[RT][2];
#pragma unroll
    for (int rt = 0; rt < RT; ++rt) {
        tq[rt] = tw0 + 4 * rt + (l >> 2);
        const bf16_t* qp = HM(g * 4 + hl, rowb + tq[rt]) + quad * 8;
        qf[rt][0] = *(const bf16x8*)qp;
        qf[rt][1] = *(const bf16x8*)(qp + 32);
    }
    f32x4 OT[RT][4];
    float lsum[RT], off[RT], zoff[RT];
#pragma unroll
    for (int rt = 0; rt < RT; ++rt) zoff[rt] = 0.f;
    auto nohook = [](int, int, int, const float*) {};
    RangeMask<RT> rm;
#pragma unroll
    for (int rt = 0; rt < RT; ++rt) { rm.t[rt] = tq[rt]; rm.selm[rt] = 0; }
    rm.tmin = t0b;
    rm.tmax = t0b + 31;
    auto flush = [&](const int br, const float (&fct)[RT]) {
#pragma unroll
        for (int rt = 0; rt < RT; ++rt) {
            uint2 pvv[4], zvv[4];
            bf16_t* op = p.MIX + (rowb + tq[rt]) * DM + (g * 4 + hl) * 64 + quad * 4;
            const bf16_t* zp = HM(20 + g * 4 + hl, rowb + tq[rt]) + quad * 4;
#pragma unroll
            for (int dt = 0; dt < 4; ++dt) {
                pvv[dt] = (br > 0) ? *(const uint2*)(op + dt * 16) : make_uint2(0u, 0u);
                zvv[dt] = (br == 2) ? *(const uint2*)(zp + dt * 16) : make_uint2(0u, 0u);
            }
#pragma unroll
            for (int dt = 0; dt < 4; ++dt) {
                float v0 = OT[rt][dt][0] * fct[rt], v1 = OT[rt][dt][1] * fct[rt], v2 = OT[rt][dt][2] * fct[rt], v3 = OT[rt][dt][3] * fct[rt];
                if (br > 0) {
                    const uint2 pv = pvv[dt];
                    v0 += __uint_as_float(pv.x << 16); v1 += __uint_as_float(pv.x & 0xffff0000u);
                    v2 += __uint_as_float(pv.y << 16); v3 += __uint_as_float(pv.y & 0xffff0000u);
                }
                if (br == 2) {
                    const uint2 z = zvv[dt];
                    v0 *= __uint_as_float(z.x << 16); v1 *= __uint_as_float(z.x & 0xffff0000u);
                    v2 *= __uint_as_float(z.y << 16); v3 *= __uint_as_float(z.y & 0xffff0000u);
                }
                uint2 o;
                o.x = cvt_pk_bf16(v0, v1);
                o.y = cvt_pk_bf16(v2, v3);
                if (br == 2) __hip_atomic_store((u64*)(op + dt * 16), ((u64)o.y << 32) | o.x, __ATOMIC_RELAXED, __HIP_MEMORY_SCOPE_AGENT);
                else *(uint2*)(op + dt * 16) = o;
            }
        }
    };
    float gts[RT][3];
#pragma unroll
    for (int rt = 0; rt < RT; ++rt)
#pragma unroll
        for (int br = 0; br < 3; ++br) gts[rt][br] = p.G[(rowb + tq[rt]) * 24 + (g * 4 + hl) * 3 + br];
    auto gatev = [&](int rt, int br) { return gts[rt][br]; };
    const int ncmp = (t0b >> 10) + 1;
    const bf16_t* Kc = p.KCc + ((size_t)b * 2 + g) * 256 * 64;
    const bf16_t* Vc = p.VCcT + ((size_t)b * 2 + g) * 64 * 256;
    rm.mode = 0;
#pragma unroll
    for (int rt = 0; rt < RT; ++rt) lsum[rt] = 0.f;
    zeroOT<RT>(OT);
    attn_tiles<RT, false, false, false, false>(Kc, 64, Vc, 256, 0, ncmp - 1, qf, OT, lsum, zoff, Ks, Vs, rm, nohook);
#pragma unroll
    for (int rt = 0; rt < RT; ++rt) {
        const float cs = quadsum(lsum[rt]);
        off[rt] = cs > 0.f ? -__log2f(cs) : 0.f;
        lsum[rt] = 0.f;
    }
    attn_tiles<RT, true, true, true, false>(Kc, 64, Vc, 256, 0, ncmp - 1, qf, OT, lsum, off, Ks, Vs, rm,
                               [&](int rt, int j, int nt, const float* pr) {
                                   float a = pr[0] + pr[1] + pr[2] + 0.5f * pr[3], bq = 0.5f * pr[3];
                                   a += __shfl_xor(a, 1);
                                   a += __shfl_xor(a, 2);
                                   bq += __shfl_xor(bq, 1);
                                   bq += __shfl_xor(bq, 2);
                                   if (hl == 0) {
                                       const int q = rt * 4 + (l >> 2), jj = j * 16 + nt * 4 + quad;
                                       impq[q * 64 + jj] = a;
                                       impb[q * 65 + jj + 1] = bq;
                                   }
                               });
    {
        float fct[RT];
#pragma unroll
        for (int rt = 0; rt < RT; ++rt) fct[rt] = gatev(rt, 0);
        flush(0, fct);
    }
#pragma unroll
    for (int rt = 0; rt < RT; ++rt) {
        u64 mysel = 0;
#pragma unroll 1
        for (int qq = 0; qq < 4; ++qq) {
            const int q = rt * 4 + qq;
            const int t = tw0 + q;
            const int j = lane;
            float v = 0.f;
            if (j < ncmp * 16) v = impq[q * 64 + j];
            if (j > 0 && j <= ncmp * 16) v += impb[q * 65 + j];
            if (j == 0 || j == cur || j == cur - 1) v = 1e6f;
            if (j * 64 > t) v = -1e30f;
            int rank = 0;
#pragma unroll
            for (int i = 0; i < 64; ++i) {
                const float vi = __int_as_float(__builtin_amdgcn_readlane(__float_as_int(v), i));
                rank += (vi > v || (vi == v && i < j)) ? 1 : 0;
            }
            const u64 m = __ballot(rank < 16);
            if ((l >> 2) == qq) mysel = m;
        }
        rm.selm[rt] = mysel;
    }
    rm.mode = 1;
#pragma unroll
    for (int rt = 0; rt < RT; ++rt) lsum[rt] = 0.f;
    zeroOT<RT>(OT);
    attn_tiles<RT, true, false, false, true>(HM(12 + g, rowb), 64, p.VT + (((size_t)0 * 4 + b) * 2 + g) * 64 * SEQ, SEQ, 0, cur - 1,
                                qf, OT, lsum, zoff, Ks, Vs, rm, nohook);
    attn_tiles<RT, true, false, false, false>(HM(12 + g, rowb), 64, p.VT + (((size_t)0 * 4 + b) * 2 + g) * 64 * SEQ, SEQ, cur, cur,
                                qf, OT, lsum, zoff, Ks, Vs, rm, nohook);
    {
        float fct[RT];
#pragma unroll
        for (int rt = 0; rt < RT; ++rt) { const float s = quadsum(lsum[rt]); fct[rt] = s > 0.f ? gatev(rt, 1) / s : 0.f; }
        flush(1, fct);
    }
    rm.mode = 2;
#pragma unroll
    for (int rt = 0; rt < RT; ++rt) lsum[rt] = 0.f;
    zeroOT<RT>(OT);
    attn_tiles<RT, true, false, false, false>(HM(16 + g, rowb), 64, p.VT + (((size_t)1 * 4 + b) * 2 + g) * 64 * SEQ, SEQ,
                                (t0b >= 511) ? ((t0b - 511) >> 6) : 0, cur, qf, OT, lsum, zoff, Ks, Vs, rm, nohook);
    {
        float fct[RT];
#pragma unroll
        for (int rt = 0; rt < RT; ++rt) { const float s = quadsum(lsum[rt]); fct[rt] = s > 0.f ? gatev(rt, 2) / s : 0.f; }
        flush(2, fct);
    }
    dep_signal(DEP_WORDS(p) + ((b * SEQ + t0b) >> 7));
}

__device__ void dsa_item(const Params& p, char* smem, int b, int g, int qt32) {
    constexpr int RT = 2;
    dep_wait(DEP_IDX(p) + b * 128 + qt32, 4u);
    const int tid = threadIdx.x, lane = tid & 63, w = __builtin_amdgcn_readfirstlane(tid >> 6), l = lane & 15, quad = lane >> 4;
    bf16_t* Ks = (bf16_t*)smem;
    bf16_t* Vs = Ks + 2 * KV_TILE;
    const int t0b = qt32 * 32, tw0 = t0b + 8 * w;
    const int hl = l & 3;
    const int cur = t0b >> 6;
    const size_t rowb = (size_t)b * SEQ;
    int tq[RT];
    bf16x8 qf[RT][2];
    BitMask<RT> bm;
    bm.quad4 = quad * 4;
    bm.slot = tid & 31;
    bm.lds = (u64*)(smem + 4 * KV_TILE * 2 + 4 * (8 * 64 + 8 * 65) * 4);
    bm.gsrc = p.MASK + (rowb + t0b + (tid & 31)) * 64;
#pragma unroll
    for (int rt = 0; rt < RT; ++rt) {
        tq[rt] = tw0 + 4 * rt + (l >> 2);
        const bf16_t* qp = HM(28 + g * 4 + hl, rowb + tq[rt]) + quad * 8;
        qf[rt][0] = *(const bf16x8*)qp;
        qf[rt][1] = *(const bf16x8*)(qp + 32);
        bm.qidx[rt] = 8 * w + 4 * rt + (l >> 2);
    }
    f32x4 OT[RT][4];
    float lsum[RT], zoff[RT];
#pragma unroll
    for (int rt = 0; rt < RT; ++rt) { lsum[rt] = 0.f; zoff[rt] = 0.f; }
    zeroOT<RT>(OT);
    auto nohook = [](int, int, int, const float*) {};
    attn_tiles<RT, true, false, false, false>(HM(36 + g, rowb), 64, p.VT + (((size_t)2 * 4 + b) * 2 + g) * 64 * SEQ, SEQ, 0, cur, qf,
                                OT, lsum, zoff, Ks, Vs, bm, nohook);
    uint2 zvv[RT][4];
#pragma unroll
    for (int rt = 0; rt < RT; ++rt) {
        const bf16_t* zp = HM(45 + g * 4 + hl, rowb + tq[rt]) + quad * 4;
#pragma unroll
        for (int dt = 0; dt < 4; ++dt) zvv[rt][dt] = *(const uint2*)(zp + dt * 16);
    }
#pragma unroll
    for (int rt = 0; rt < RT; ++rt) {
        const float s = quadsum(lsum[rt]);
        const float fct = s > 0.f ? 1.f / s : 0.f;
        bf16_t* op = p.MIX + (rowb + tq[rt]) * DM + 512 + (g * 4 + hl) * 64 + quad * 4;
#pragma unroll
        for (int dt = 0; dt < 4; ++dt) {
            const uint2 z = zvv[rt][dt];
            uint2 o;
            o.x = cvt_pk_bf16(OT[rt][dt][0] * fct * __uint_as_float(z.x << 16), OT[rt][dt][1] * fct * __uint_as_float(z.x & 0xffff0000u));
            o.y = cvt_pk_bf16(OT[rt][dt][2] * fct * __uint_as_float(z.y << 16), OT[rt][dt][3] * fct * __uint_as_float(z.y & 0xffff0000u));
            __hip_atomic_store((u64*)(op + dt * 16), ((u64)o.y << 32) | o.x, __ATOMIC_RELAXED, __HIP_MEMORY_SCOPE_AGENT);
        }
    }
    dep_signal(DEP_WORDS(p) + ((b * SEQ + t0b) >> 7));
}

__device__ __forceinline__ int next_item(int* ctr, int* slot) {
    __syncthreads();
    if (threadIdx.x == 0) *slot = atomicAdd(ctr, 1);
    __syncthreads();
    return *slot;
}

__device__ void phase3(const Params& p, char* smem, int* ctr) {
    int* slot = (int*)(smem + SMEM_BYTES - 16);
    int q = hw_xcc_id() & 7, tries = 0;
    for (;;) {
        const int it = next_item_xcd(ctr, slot, q, tries, 256);
        if (it < 0) break;
        const int qt = 127 - (it >> 1);
        if (it & 1) nsa_item(p, smem, q >> 1, q & 1, qt);
        else dsa_item(p, smem, q >> 1, q & 1, qt);
    }
}

#define XB_TMO      128
#define XB_XCNT(j)  (256  + 64 * (j))
#define XB_XSUB(j)  (1280 + 64 * (j))
#define XB_XGEN(j)  (2304 + 64 * (j))
#define XB_TOP      3328
#define XB_TOPGEN   3392
#define XCD_BAR_WORDS 3456
#define XB_SPIN_CAP (1u << 18)
#define LAS __attribute__((address_space(3)))

__device__ __forceinline__ unsigned xb_ld(unsigned* p)              { return __hip_atomic_load(p, __ATOMIC_RELAXED, __HIP_MEMORY_SCOPE_AGENT); }
__device__ __forceinline__ unsigned xb_add(unsigned* p, unsigned v) { return __hip_atomic_fetch_add(p, v, __ATOMIC_RELAXED, __HIP_MEMORY_SCOPE_AGENT); }
__device__ __forceinline__ unsigned xb_xcc_id() { return (unsigned)__builtin_amdgcn_s_getreg((3 << 11) | 20) & 0xFu; }
#define XB_SPIN(cond, bar) do { unsigned _sp = 0; while (cond) { __builtin_amdgcn_s_sleep(1); \
    if ((++_sp & 255u) == 0u) { if (xb_ld(&(bar)[XB_TMO])) break; if (_sp > XB_SPIN_CAP) { atomicAdd(&(bar)[XB_TMO], 1u); break; } } } } while (0)

struct XcdBarrier {
    unsigned* bar; unsigned x;
    volatile LAS unsigned* st;
};

__device__ __forceinline__ XcdBarrier xcd_barrier_post(unsigned* bar, volatile LAS unsigned* st) {
    XcdBarrier b; b.bar = bar; b.x = xb_xcc_id(); b.st = st;
    if (threadIdx.x == 0) (void)xb_add(&bar[XB_XCNT(b.x)], 1u);
    return b;
}
__device__ __forceinline__ void xcd_barrier_complete(unsigned* bar, unsigned x, unsigned& nloc, unsigned& nx) {
    const unsigned G = gridDim.x * gridDim.y * gridDim.z;
    unsigned sum, cnt, mine, sp = 0u;
    for (;;) {
        sum = 0u; cnt = 0u; mine = 0u;
#pragma unroll
        for (unsigned j = 0; j < 16; ++j) { const unsigned c = xb_ld(&bar[XB_XCNT(j)]); sum += c; cnt += (c > 0u) ? 1u : 0u; mine = (j == x) ? c : mine; }
        if (sum == G) break;
        __builtin_amdgcn_s_sleep(1);
        if ((++sp & 255u) == 0u) { if (xb_ld(&bar[XB_TMO])) break; if (sp > XB_SPIN_CAP) { atomicAdd(&bar[XB_TMO], 1u); break; } }
    }
    nloc = mine > 0u ? mine : 1u; nx = cnt > 0u ? cnt : 1u;
}

__device__ __forceinline__ void xcd_barrier(const XcdBarrier& b) {
    asm volatile("s_waitcnt vmcnt(0)" ::: "memory");
    __syncthreads();
    if (threadIdx.x == 0) {
        unsigned* bar = b.bar;
        __builtin_amdgcn_s_waitcnt(0);
        unsigned nloc = b.st[0], nx = b.st[1];
        if (nloc == 0u) { xcd_barrier_complete(bar, b.x, nloc, nx); b.st[0] = nloc; b.st[1] = nx; }
        const unsigned old = xb_add(&bar[XB_XSUB(b.x)], 1u);
        const unsigned gen = old / nloc;
        if (old + 1u == (gen + 1u) * nloc) {
            __builtin_amdgcn_fence(__ATOMIC_RELEASE, "agent");
            asm volatile("s_waitcnt vmcnt(0)" ::: "memory");
            const unsigned og = xb_add(&bar[XB_TOP], 1u);
            const unsigned tg = og / nx;
            if (og + 1u == (tg + 1u) * nx) xb_add(&bar[XB_TOPGEN], 1u);
            else XB_SPIN(xb_ld(&bar[XB_TOPGEN]) == tg, bar);
            __builtin_amdgcn_fence(__ATOMIC_ACQUIRE, "agent");
            xb_add(&bar[XB_XGEN(b.x)], 1u);
            asm volatile("s_waitcnt vmcnt(0)" ::: "memory");
        } else {
            XB_SPIN(xb_ld(&bar[XB_XGEN(b.x)]) == gen, bar);
            __builtin_amdgcn_fence(__ATOMIC_ACQUIRE, "agent");
            asm volatile("s_waitcnt vmcnt(0)" ::: "memory");
        }
    }
    __syncthreads();
}


#if COOP
__global__ void __launch_bounds__(256, 2) mega(Params p) {
    __shared__ __attribute__((aligned(16))) char smem[SMEM_BYTES];
    __shared__ uint4 xb_words;
    cg::grid_group grid = cg::this_grid();
    const int bid = blockIdx.x, nb = gridDim.x;
    if (threadIdx.x == 0) xb_words = make_uint4(0u, 0u, 0u, 0u);
    __syncthreads();
    XcdBarrier xb = xcd_barrier_post(p.bar, (volatile LAS unsigned*)&xb_words);
    if (p.bar == nullptr) grid.sync();
    phase0(p, smem, bid, nb);
    xcd_barrier(xb);
#ifndef R1
#define R1 1
#define R2 1
#define R3 1
#define R4 1
#endif
    for (int r = 0; r < R1; ++r) { phase1(p, smem, p.ctr + 256 + r * 512); xcd_barrier(xb); }
    for (int r = 0; r < R2; ++r) { phase2(p, smem, p.ctr + r * 512); }
    for (int r = 0; r < R3; ++r) { phase3(p, smem, p.ctr + 128 + r * 512); }
    for (int r = 0; r < R4; ++r) { phase4(p, smem, p.ctr + 384 + r * 512); }
}
#else
template <int PH>
__global__ void __launch_bounds__(256, 2) kphase(Params p) {
    __shared__ __attribute__((aligned(16))) char smem[SMEM_BYTES];
    const int bid = blockIdx.x, nb = gridDim.x;
    if (PH == 0) phase0(p, smem, bid, nb);
    if (PH == 1) phase1(p, smem, p.ctr + 256);
    if (PH == 2) phase2(p, smem, p.ctr);
    if (PH == 3) phase3(p, smem, p.ctr + 128);
    if (PH == 4) phase4(p, smem, p.ctr + 384);
}
#endif

extern "C" void kernel_launch(void* const* d_in, const int* in_sizes, int n_in, void* d_out, int out_size, void* d_ws,
                              size_t ws_size, hipStream_t stream) {
    Params p{};
    const float** f = (const float**)&p;
    for (int i = 0; i < 18; ++i) f[i] = (const float*)d_in[i];
    p.out = (float*)d_out;
    char* ws = (char*)d_ws;
    size_t off = 0;
    auto take = [&](size_t bytes) { char* r = ws + off; off += (bytes + 255) & ~(size_t)255; return r; };
    p.h = (bf16_t*)take((size_t)MROWS * DM * 2);
    p.WinT = (bf16_t*)take((size_t)NP * 1024 * 2);
    p.WoutT = (bf16_t*)take((size_t)1024 * 1024 * 2);
    p.W1kT = (bf16_t*)take((size_t)256 * 2048 * 2);
    p.W1vT = (bf16_t*)take((size_t)256 * 2048 * 2);
    p.W2kT = (bf16_t*)take((size_t)64 * 256 * 2);
    p.W2vT = (bf16_t*)take((size_t)64 * 256 * 2);
    p.P = (bf16_t*)take((size_t)MROWS * NP * 2);
    p.VT = (bf16_t*)take((size_t)3 * 4 * 2 * 64 * SEQ * 2);
    p.KCc = (bf16_t*)take((size_t)8 * 256 * 64 * 2);
    p.VCcT = (bf16_t*)take((size_t)8 * 64 * 256 * 2);
    p.MIX = (bf16_t*)take((size_t)MROWS * DM * 2);
    p.ropecs = (float2*)take((size_t)SEQ * 32 * 8);
    p.G = (float*)take((size_t)MROWS * 24 * 4);
    p.WI = (float*)take((size_t)MROWS * 4 * 4);
    p.MASK = (u64*)take((size_t)MROWS * 64 * 8);
    p.bar = (unsigned*)take((size_t)XCD_BAR_WORDS * 4);
    p.ctr = (int*)take(8192);
    hipMemsetAsync(p.bar, 0, (size_t)((XCD_BAR_WORDS * 4 + 255) & ~255) + 8192, stream);
#if COOP
    static int grid_blocks = 0;
    if (!grid_blocks) {
        int dev = 0, cus = 0, per_cu = 0;
        hipGetDevice(&dev);
        hipDeviceGetAttribute(&cus, hipDeviceAttributeMultiprocessorCount, dev);
        hipOccupancyMaxActiveBlocksPerMultiprocessor(&per_cu, mega, 256, 0);
        if (per_cu > 2) per_cu = 2;
        grid_blocks = cus * per_cu;
    }
    void* args[] = {&p};
    hipError_t e = hipLaunchCooperativeKernel((void*)mega, dim3(grid_blocks), dim3(256), args, 0, stream);
    if (e != hipSuccess) fprintf(stderr, "cooperative launch failed: %s (grid %d)\n", hipGetErrorString(e), grid_blocks);
#else
    const int nb = 1024;
    kphase<0><<<nb, 256, 0, stream>>>(p);
    kphase<1><<<nb, 256, 0, stream>>>(p);
    kphase<2><<<nb, 256, 0, stream>>>(p);
    kphase<3><<<nb, 256, 0, stream>>>(p);
    kphase<4><<<nb, 256, 0, stream>>>(p);
#endif
}
```

```cpp
#include <hip/hip_runtime.h>
#include <hip/hip_cooperative_groups.h>
#include <stdint.h>
#include <cstdio>
#include <type_traits>
namespace cg = cooperative_groups;

#ifndef COOP
#define COOP 1
#endif

typedef unsigned short bf16_t;
typedef short bf16x8 __attribute__((ext_vector_type(8)));
typedef float f32x4 __attribute__((ext_vector_type(4)));
typedef unsigned long long u64;

#define MFMA(a, b, c) __builtin_amdgcn_mfma_f32_16x16x32_bf16(a, b, c, 0, 0, 0)

constexpr int SEQ = 4096, DM = 1024, MROWS = 16384, NP = 3456, INC = 3420;
constexpr int C_QN = 0, C_KC = 512, C_VC = 640, C_KS = 768, C_KW = 1024, C_ZN = 1280, C_QD = 1792, C_KD = 2304,
              C_QI = 2560, C_KI = 2816, C_ZD = 2880;
constexpr float LOG2E = 1.4426950408889634f;
constexpr int SMEM_BYTES = 73728;

struct Params {
    const float *x, *norm_gain, *w_in, *nsa_q_gain, *nsa_kc_gain, *nsa_ks_gain, *nsa_kw_gain, *cmp_pe_k, *cmp_k_w1,
        *cmp_k_b1, *cmp_k_w2, *cmp_pe_v, *cmp_v_w1, *cmp_v_b1, *cmp_v_w2, *dsa_q_gain, *dsa_k_gain, *w_out;
    float* out;
    bf16_t *h, *WinT, *WoutT, *W1kT, *W1vT, *W2kT, *W2vT, *P, *VT, *KCc, *VCcT, *MIX;
    float2* ropecs;
    float *G, *WI;
    u64* MASK;
    int* ctr;
    unsigned* bar;
};

__device__ __forceinline__ unsigned cvt_pk_bf16(float lo, float hi) {
    unsigned r;
    asm("v_cvt_pk_bf16_f32 %0, %1, %2" : "=v"(r) : "v"(lo), "v"(hi));
    return r;
}
__device__ __forceinline__ bf16_t f2bf(float f) { return (bf16_t)(cvt_pk_bf16(f, 0.f) & 0xffff); }
__device__ __forceinline__ float bf2f(bf16_t h) { return __uint_as_float(((unsigned)h) << 16); }
__device__ __forceinline__ float fast_exp2(float x) { return __builtin_amdgcn_exp2f(x); }
__device__ __forceinline__ float sigmoidf_(float v) { return __builtin_amdgcn_rcpf(1.f + fast_exp2(-v * LOG2E)); }

#define HM(gi, r) (p.P + ((size_t)(gi) * MROWS + (size_t)(r)) * 64)

__device__ __forceinline__ int colmap(int c) {
    if (c < 1280) return c;
    if (c < 2880) return c + 24;
    if (c < 3392) return c + 28;
    if (c < 3416) return 1280 + (c - 3392);
    if (c < 3420) return 2904 + (c - 3416);
    return -1;
}

__device__ __forceinline__ void transpose_tile(const float* __restrict__ src, int ldsrc, bf16_t* __restrict__ dst, int K,
                                               int k0, int n0, bool mapped, float* lds, bool frag = false) {
    const int tid = threadIdx.x;
    for (int e = tid; e < 4096; e += 256) {
        int r = e >> 6, c = e & 63;
        int oc = mapped ? colmap(n0 + c) : (n0 + c);
        lds[r * 65 + c] = (oc >= 0) ? src[(size_t)(k0 + r) * ldsrc + oc] : 0.f;
    }
    __syncthreads();
    {
        int n = tid >> 2, kk = (tid & 3) * 16;
        unsigned pk[8];
#pragma unroll
        for (int i = 0; i < 8; ++i) pk[i] = cvt_pk_bf16(lds[(kk + 2 * i) * 65 + n], lds[(kk + 2 * i + 1) * 65 + n]);
        if (frag) {
            const int ng = n0 + n;
#pragma unroll
            for (int c = 0; c < 2; ++c) {
                const int k = k0 + kk + 8 * c;
                uint4* d = (uint4*)(dst + ((((size_t)(ng >> 4) * (K >> 5) + (k >> 5)) * 64) + ((k >> 3) & 3) * 16 + (ng & 15)) * 8);
                *d = make_uint4(pk[4 * c], pk[4 * c + 1], pk[4 * c + 2], pk[4 * c + 3]);
            }
        } else {
            uint4* d = (uint4*)(dst + (size_t)(n0 + n) * K + k0 + kk);
            d[0] = make_uint4(pk[0], pk[1], pk[2], pk[3]);
            d[1] = make_uint4(pk[4], pk[5], pk[6], pk[7]);
        }
    }
    __syncthreads();
}

__device__ void phase0(const Params& p, char* smem, int bid, int nb) {
    const int tid = threadIdx.x, lane = tid & 63, w = __builtin_amdgcn_readfirstlane(tid >> 6);
    float* lds = (float*)smem;
    constexpr int N_RMS = 2048, N_TR = 864 + 256 + 128 + 128 + 4 + 4, N_ROPE = 512;
    constexpr int TOTAL = N_RMS + N_TR + N_ROPE + 1;
    for (int it = bid; it < TOTAL; it += nb) {
        if (it < N_RMS) {
            const int row0 = it * 8 + w * 2;
            float4 v[2][4];
            float ss[2] = {0.f, 0.f};
#pragma unroll
            for (int rr = 0; rr < 2; ++rr) {
                const float4* xr = (const float4*)(p.x + (size_t)(row0 + rr) * DM);
#pragma unroll
                for (int i = 0; i < 4; ++i) v[rr][i] = xr[lane + 64 * i];
            }
            float4 g[4];
#pragma unroll
            for (int i = 0; i < 4; ++i) g[i] = ((const float4*)p.norm_gain)[lane + 64 * i];
#pragma unroll
            for (int rr = 0; rr < 2; ++rr) {
#pragma unroll
                for (int i = 0; i < 4; ++i)
                    ss[rr] += v[rr][i].x * v[rr][i].x + v[rr][i].y * v[rr][i].y + v[rr][i].z * v[rr][i].z + v[rr][i].w * v[rr][i].w;
#pragma unroll
                for (int m = 32; m >= 1; m >>= 1) ss[rr] += __shfl_xor(ss[rr], m);
                const float rstd = rsqrtf(ss[rr] * (1.f / DM) + 1e-6f);
#pragma unroll
                for (int i = 0; i < 4; ++i) {
                    uint2 o;
                    o.x = cvt_pk_bf16(v[rr][i].x * rstd * g[i].x, v[rr][i].y * rstd * g[i].y);
                    o.y = cvt_pk_bf16(v[rr][i].z * rstd * g[i].z, v[rr][i].w * rstd * g[i].w);
                    *(uint2*)(p.h + (size_t)(row0 + rr) * DM + (lane + 64 * i) * 4) = o;
                }
            }
        } else if (it < N_RMS + N_TR) {
            int i = it - N_RMS;
            if (i < 864) {
                transpose_tile(p.w_in, INC, p.WinT, 1024, (i / 54) * 64, (i % 54) * 64, true, lds);
            } else if ((i -= 864) < 256) {
                transpose_tile(p.w_out, 1024, p.WoutT, 1024, (i / 16) * 64, (i % 16) * 64, false, lds);
            } else if ((i -= 256) < 128) {
                transpose_tile(p.cmp_k_w1, 256, p.W1kT, 2048, (i / 4) * 64, (i % 4) * 64, false, lds, true);
            } else if ((i -= 128) < 128) {
                transpose_tile(p.cmp_v_w1, 256, p.W1vT, 2048, (i / 4) * 64, (i % 4) * 64, false, lds, true);
            } else if ((i -= 128) < 4) {
                transpose_tile(p.cmp_k_w2, 64, p.W2kT, 256, i * 64, 0, false, lds);
            } else {
                i -= 4;
                transpose_tile(p.cmp_v_w2, 64, p.W2vT, 256, i * 64, 0, false, lds);
            }
        } else if (it < N_RMS + N_TR + N_ROPE) {
            int e = (it - N_RMS - N_TR) * 256 + tid;
            int t = e >> 5, d = e & 31;
            float inv = powf(10000.f, -(float)d / 32.f);
            float ang = (float)t * inv;
            p.ropecs[e] = make_float2(cosf(ang), sinf(ang));
        } else {
            for (int e = tid; e < 512; e += 256) {
                int bg = e >> 6, d = e & 63;
                p.KCc[((size_t)bg * 256 + 255) * 64 + d] = 0;
                p.VCcT[((size_t)bg * 64 + d) * 256 + 255] = 0;
            }
        }
    }
}

template <int EPI>
__device__ __forceinline__ void gemm_tile(const bf16_t* __restrict__ A, const bf16_t* __restrict__ Bt, int m0, int n0,
                                          char* smem, const Params& p) {
    constexpr int K = 1024, KT = K / 64, LR = 72;
    bf16_t* As = (bf16_t*)smem;
    bf16_t* Bs = As + 2 * 128 * LR;
    const int tid = threadIdx.x, lane = tid & 63, w = __builtin_amdgcn_readfirstlane(tid >> 6), wr = w >> 1, wc = w & 1, l = lane & 15, quad = lane >> 4;
    f32x4 acc[4][4];
#pragma unroll
    for (int i = 0; i < 4; ++i)
#pragma unroll
        for (int j = 0; j < 4; ++j) acc[i][j] = (f32x4){0.f, 0.f, 0.f, 0.f};
    const int srow = tid >> 3, scol = (tid & 7) * 8;
    const bf16_t* ga = A + (size_t)(m0 + srow) * K + scol;
    const bf16_t* gb = Bt + (size_t)(n0 + srow) * K + scol;
    bf16x8 ra[4], rb[4], rc[4], rd[4];
    auto ldt = [&](int kt, bf16x8 (&xa)[4], bf16x8 (&xb)[4]) {
#pragma unroll
        for (int i = 0; i < 4; ++i) {
            xa[i] = *(const bf16x8*)(ga + (size_t)i * 32 * K + kt * 64);
            xb[i] = *(const bf16x8*)(gb + (size_t)i * 32 * K + kt * 64);
        }
    };
    auto stt = [&](int buf, const bf16x8 (&xa)[4], const bf16x8 (&xb)[4]) {
#pragma unroll
        for (int i = 0; i < 4; ++i) {
            *(bf16x8*)(As + buf * 128 * LR + (srow + 32 * i) * LR + scol) = xa[i];
            *(bf16x8*)(Bs + buf * 128 * LR + (srow + 32 * i) * LR + scol) = xb[i];
        }
    };
    auto comp = [&](int cur) {
        const bf16_t* Ab = As + cur * 128 * LR + (wr * 64 + l) * LR + quad * 8;
        const bf16_t* Bb = Bs + cur * 128 * LR + (wc * 64 + l) * LR + quad * 8;
#pragma unroll
        for (int ks = 0; ks < 2; ++ks) {
            if (ks == 1) __builtin_amdgcn_sched_barrier(0);
            bf16x8 af[4], bfr[4];
#pragma unroll
            for (int i = 0; i < 4; ++i) {
                af[i] = *(const bf16x8*)(Ab + i * 16 * LR + ks * 32);
                bfr[i] = *(const bf16x8*)(Bb + i * 16 * LR + ks * 32);
            }
#pragma unroll
            for (int i = 0; i < 4; ++i)
#pragma unroll
                for (int j = 0; j < 4; ++j) acc[i][j] = MFMA(af[i], bfr[j], acc[i][j]);
        }
    };
    ldt(0, ra, rb);
    ldt(1, rc, rd);
    stt(0, ra, rb);
    __syncthreads();
#pragma unroll 1
    for (int kt = 0; kt < KT; kt += 2) {
        ldt(kt + 2 < KT ? kt + 2 : KT - 1, ra, rb);
        comp(0);
        stt(1, rc, rd);
        __syncthreads();
        ldt(kt + 3 < KT ? kt + 3 : KT - 1, rc, rd);
        comp(1);
        stt(0, ra, rb);
        __syncthreads();
    }
    if (EPI == 1) {
        float xv[4][4][4];
#pragma unroll
        for (int mi = 0; mi < 4; ++mi)
#pragma unroll
            for (int r = 0; r < 4; ++r)
#pragma unroll
                for (int ni = 0; ni < 4; ++ni)
                    xv[mi][r][ni] = p.x[((size_t)m0 + wr * 64 + mi * 16 + quad * 4 + r) * DM + n0 + wc * 64 + ni * 16 + l];
#pragma unroll
        for (int mi = 0; mi < 4; ++mi)
#pragma unroll
            for (int r = 0; r < 4; ++r)
#pragma unroll
                for (int ni = 0; ni < 4; ++ni)
                    p.out[((size_t)m0 + wr * 64 + mi * 16 + quad * 4 + r) * DM + n0 + wc * 64 + ni * 16 + l] = xv[mi][r][ni] + acc[mi][ni][r];
        return;
    }
    const int gidx = (n0 >> 6) + wc;
    int type = 0, vtw = 0;
    float scale = 1.f;
    const float* gain = nullptr;
    if (gidx < 8) { type = 1; gain = p.nsa_q_gain; scale = 0.125f * LOG2E; }
    else if (gidx < 12) { type = 0; }
    else if (gidx < 14) { type = 1; gain = p.nsa_ks_gain; }
    else if (gidx < 16) { type = 3; vtw = 0; }
    else if (gidx < 18) { type = 1; gain = p.nsa_kw_gain; }
    else if (gidx < 20) { type = 3; vtw = 1; }
    else if (gidx < 28) { type = 4; }
    else if (gidx < 36) { type = 1; gain = p.dsa_q_gain; scale = 0.125f * LOG2E; }
    else if (gidx < 38) { type = 1; gain = p.dsa_k_gain; }
    else if (gidx < 40) { type = 3; vtw = 2; }
    else if (gidx < 44) { type = 2; scale = 0.125f; }
    else if (gidx < 45) { type = 2; }
    else if (gidx < 53) { type = 4; }
    else { type = 5; }

    if (type == 3) {
        const int g = gidx & 1;
#pragma unroll
        for (int mi = 0; mi < 4; ++mi) {
            int row = m0 + wr * 64 + mi * 16 + quad * 4;
            int b = row >> 12, t = row & 4095;
#pragma unroll
            for (int ni = 0; ni < 4; ++ni) {
                int dim = ni * 16 + l;
                uint2 o;
                o.x = cvt_pk_bf16(acc[mi][ni][0], acc[mi][ni][1]);
                o.y = cvt_pk_bf16(acc[mi][ni][2], acc[mi][ni][3]);
                *(uint2*)(p.VT + ((((size_t)vtw * 4 + b) * 2 + g) * 64 + dim) * SEQ + t) = o;
            }
        }
        return;
    }
    float gn[4] = {1.f, 1.f, 1.f, 1.f};
    if (type == 1) {
#pragma unroll
        for (int ni = 0; ni < 4; ++ni) gn[ni] = gain[ni * 16 + l];
    }
    auto store_row = [&](int row, const float (&v)[4]) {
        if (gidx == 44) {
            bf16_t* o = HM(44, 0) + (size_t)(row >> 4) * 1024 + (row & 15) * 8 + (l & 7);
#pragma unroll
            for (int ni = 0; ni < 4; ++ni) o[(ni >> 1) * 512 + ((ni & 1) * 2 + (l >> 3)) * 128] = f2bf(v[ni]);
        } else {
            bf16_t* o = HM(gidx, row) + l;
#pragma unroll
            for (int ni = 0; ni < 4; ++ni) o[ni * 16] = f2bf(v[ni]);
        }
    };
    const int rowbase = m0 + wr * 64 + quad * 4;
    if (type == 5) {
#pragma unroll
        for (int mi = 0; mi < 4; ++mi)
#pragma unroll
            for (int r = 0; r < 4; ++r) {
                const int row = rowbase + mi * 16 + r;
#pragma unroll
                for (int ni = 0; ni < 2; ++ni) {
                    const int d = ni * 16 + l;
                    if (d < 24) p.G[(size_t)row * 24 + d] = sigmoidf_(acc[mi][ni][r]);
                    else if (d < 28) p.WI[(size_t)row * 4 + (d - 24)] = acc[mi][ni][r] * 0.5f;
                }
            }
    } else if (type == 1 || type == 2) {
        float2 cs[4][4][2];
#pragma unroll
        for (int mi = 0; mi < 4; ++mi)
#pragma unroll
            for (int r = 0; r < 4; ++r) {
                const int t = (rowbase + mi * 16 + r) & 4095;
#pragma unroll
                for (int ni = 0; ni < 2; ++ni) cs[mi][r][ni] = p.ropecs[t * 32 + ni * 16 + l];
            }
#pragma unroll
        for (int mi = 0; mi < 4; ++mi)
#pragma unroll
            for (int r = 0; r < 4; ++r) {
                float v[4];
#pragma unroll
                for (int ni = 0; ni < 4; ++ni) v[ni] = acc[mi][ni][r];
                if (type == 1) {
                    float ss = v[0] * v[0] + v[1] * v[1] + v[2] * v[2] + v[3] * v[3];
                    ss += __shfl_xor(ss, 1);
                    ss += __shfl_xor(ss, 2);
                    ss += __shfl_xor(ss, 4);
                    ss += __shfl_xor(ss, 8);
                    const float rstd = rsqrtf(ss * (1.f / 64.f) + 1e-6f);
#pragma unroll
                    for (int ni = 0; ni < 4; ++ni) v[ni] = v[ni] * rstd * gn[ni];
                }
#pragma unroll
                for (int ni = 0; ni < 2; ++ni) {
                    const float c = cs[mi][r][ni].x, sn = cs[mi][r][ni].y;
                    const float x1 = v[ni], x2 = v[ni + 2];
                    v[ni] = (x1 * c - x2 * sn) * scale;
                    v[ni + 2] = (x2 * c + x1 * sn) * scale;
                }
                store_row(rowbase + mi * 16 + r, v);
            }
    } else {
#pragma unroll
        for (int mi = 0; mi < 4; ++mi)
#pragma unroll
            for (int r = 0; r < 4; ++r) {
                float v[4];
#pragma unroll
                for (int ni = 0; ni < 4; ++ni) v[ni] = acc[mi][ni][r];
                if (type == 4) {
#pragma unroll
                    for (int ni = 0; ni < 4; ++ni) v[ni] = v[ni] * sigmoidf_(v[ni]);
                }
                store_row(rowbase + mi * 16 + r, v);
            }
    }
}

__device__ void phase1(const Params& p, char* smem, int* ctr);
__device__ void phase4(const Params& p, char* smem, int* ctr);


#define DEP_WORDS(p) ((unsigned*)((p).ctr + 1024))
__device__ __forceinline__ void dep_signal(unsigned* word, bool release_l2 = false) {
    asm volatile("s_waitcnt vmcnt(0)" ::: "memory");
    __syncthreads();
    if (threadIdx.x == 0) {
        if (release_l2) {
            __builtin_amdgcn_fence(__ATOMIC_RELEASE, "agent");
            asm volatile("s_waitcnt vmcnt(0)" ::: "memory");
        }
        __hip_atomic_fetch_add(word, 1u, __ATOMIC_RELAXED, __HIP_MEMORY_SCOPE_AGENT);
    }
}
#define DEP_IDX(p) (DEP_WORDS(p) + 128)
#define DEP_CMP(p) (DEP_WORDS(p) + 640)
__device__ __forceinline__ void dep_wait(unsigned* word, unsigned want) {
    if (threadIdx.x == 0) {
        unsigned spins = 0;
        while (__hip_atomic_load(word, __ATOMIC_RELAXED, __HIP_MEMORY_SCOPE_AGENT) < want) {
            __builtin_amdgcn_s_sleep(1);
            if (++spins > (1u << 22)) break;
        }
        __builtin_amdgcn_fence(__ATOMIC_ACQUIRE, "agent");
        asm volatile("s_waitcnt vmcnt(0)" ::: "memory");
    }
    __syncthreads();
}

__device__ void compress_item(const Params& p, char* smem, int ci) {
    const int tid = threadIdx.x, lane = tid & 63, w = __builtin_amdgcn_readfirstlane(tid >> 6), l = lane & 15, quad = lane >> 4;
    const int kv = ci >> 7, rt = ci & 127, rho0 = rt * 16;
    const bf16_t* W1T = kv ? p.W1vT : p.W1kT;
    const bf16_t* W2T = kv ? p.W2vT : p.W2kT;
    const float* pe = kv ? p.cmp_pe_v : p.cmp_pe_k;
    const float* b1 = kv ? p.cmp_v_b1 : p.cmp_k_b1;
    bf16_t* hid = (bf16_t*)smem;
    float* outf = (float*)(smem + 16 * 264 * 2);
    constexpr int ALD = 2056;
    bf16_t* As = (bf16_t*)smem;
#pragma unroll 4
    for (int i = 0; i < 16; ++i) {
        const int cidx = tid + 256 * i, row = cidx >> 8, k = (cidx & 255) * 8;
        int rho = rho0 + row;
        if (rho > 2039) rho = 2039;
        const int bb_ = rho / 510, rem = rho % 510, cc = rem >> 1, gg = rem & 1;
        const int lrow = k >> 6, d0 = k & 63;
        const bf16x8 raw = *(const bf16x8*)(HM((kv ? 10 : 8) + gg, (size_t)bb_ * SEQ + cc * 16 + lrow) + d0);
        const float4* pp = (const float4*)(pe + lrow * 64 + d0);
        const float4 p0 = pp[0], p1 = pp[1];
        union { bf16x8 v; unsigned u[4]; } a;
        a.u[0] = cvt_pk_bf16(bf2f((bf16_t)raw[0]) + p0.x, bf2f((bf16_t)raw[1]) + p0.y);
        a.u[1] = cvt_pk_bf16(bf2f((bf16_t)raw[2]) + p0.z, bf2f((bf16_t)raw[3]) + p0.w);
        a.u[2] = cvt_pk_bf16(bf2f((bf16_t)raw[4]) + p1.x, bf2f((bf16_t)raw[5]) + p1.y);
        a.u[3] = cvt_pk_bf16(bf2f((bf16_t)raw[6]) + p1.z, bf2f((bf16_t)raw[7]) + p1.w);
        *(bf16x8*)(As + row * ALD + k) = a.v;
    }
    const bf16_t* brow = W1T + (size_t)(w * 4) * 64 * 512 + lane * 8;
    f32x4 acc[4];
#pragma unroll
    for (int i = 0; i < 4; ++i) acc[i] = (f32x4){0.f, 0.f, 0.f, 0.f};
    {
        bf16x8 X[4], Y[4];
        auto bload = [&](int ks, bf16x8 (&st)[4]) {
#pragma unroll
            for (int ni = 0; ni < 4; ++ni) st[ni] = *(const bf16x8*)(brow + ((size_t)ni * 64 + ks) * 512);
        };
        bload(0, X);
        bload(1, Y);
        __syncthreads();
        const bf16_t* arow = As + l * ALD + quad * 8;
#pragma unroll 1
        for (int ks = 0; ks < 64; ks += 2) {
            const bf16x8 a0 = *(const bf16x8*)(arow + ks * 32), a1 = *(const bf16x8*)(arow + ks * 32 + 32);
#pragma unroll
            for (int ni = 0; ni < 4; ++ni) acc[ni] = MFMA(a0, X[ni], acc[ni]);
            bload(ks + 2 < 64 ? ks + 2 : 63, X);
#pragma unroll
            for (int ni = 0; ni < 4; ++ni) acc[ni] = MFMA(a1, Y[ni], acc[ni]);
            bload(ks + 3 < 64 ? ks + 3 : 63, Y);
        }
    }
    __syncthreads();
    float biasv[4];
#pragma unroll
    for (int ni = 0; ni < 4; ++ni) biasv[ni] = b1[w * 64 + ni * 16 + l];
#pragma unroll
    for (int ni = 0; ni < 4; ++ni) {
        int col = w * 64 + ni * 16 + l;
        float bias = biasv[ni];
#pragma unroll
        for (int r = 0; r < 4; ++r) {
            float v = acc[ni][r] + bias;
            v = v * sigmoidf_(v);
            hid[(quad * 4 + r) * 264 + col] = f2bf(v);
        }
    }
    __syncthreads();
    {
        f32x4 a2 = (f32x4){0.f, 0.f, 0.f, 0.f};
#pragma unroll
        for (int ks = 0; ks < 8; ++ks) {
            bf16x8 a = *(const bf16x8*)(hid + l * 264 + ks * 32 + quad * 8);
            bf16x8 bb = *(const bf16x8*)(W2T + (size_t)(w * 16 + l) * 256 + ks * 32 + quad * 8);
            a2 = MFMA(a, bb, a2);
        }
#pragma unroll
        for (int r = 0; r < 4; ++r) outf[(quad * 4 + r) * 64 + w * 16 + l] = a2[r];
    }
    __syncthreads();
    {
        const int row = tid >> 4, j = tid & 15;
        const int rr = rho0 + row;
        float v[4];
#pragma unroll
        for (int i = 0; i < 4; ++i) v[i] = outf[row * 64 + j + 16 * i];
        const int rb = (rr < 2040) ? rr : 2039;
        const int b2 = rb / 510, rem2 = rb % 510, c2 = rem2 >> 1, g2 = rem2 & 1;
        if (kv == 0) {
            float ss = v[0] * v[0] + v[1] * v[1] + v[2] * v[2] + v[3] * v[3];
            ss += __shfl_xor(ss, 1);
            ss += __shfl_xor(ss, 2);
            ss += __shfl_xor(ss, 4);
            ss += __shfl_xor(ss, 8);
            float rstd = rsqrtf(ss * (1.f / 64.f) + 1e-6f);
#pragma unroll
            for (int i = 0; i < 4; ++i) v[i] = v[i] * rstd * p.nsa_kc_gain[j + 16 * i];
            const int pos = c2 * 16 + 31;
#pragma unroll
            for (int i = 0; i < 2; ++i) {
                const float2 csv = p.ropecs[pos * 32 + j + 16 * i];
                float cc = csv.x, s = csv.y;
                float x1 = v[i], x2 = v[i + 2];
                v[i] = x1 * cc - x2 * s;
                v[i + 2] = x2 * cc + x1 * s;
            }
            if (rr < 2040) {
#pragma unroll
                for (int i = 0; i < 4; ++i) p.KCc[(((size_t)b2 * 2 + g2) * 256 + c2) * 64 + j + 16 * i] = f2bf(v[i]);
            }
        } else {
            if (rr < 2040) {
#pragma unroll
                for (int i = 0; i < 4; ++i) p.VCcT[(((size_t)b2 * 2 + g2) * 64 + j + 16 * i) * 256 + c2] = f2bf(v[i]);
            }
        }
    }
    dep_signal(DEP_CMP(p), true);
    __syncthreads();
}

__device__ void indexer_item(const Params& p, char* smem, int u) {
    const int tid = threadIdx.x, lane = tid & 63, w = __builtin_amdgcn_readfirstlane(tid >> 6), l = lane & 15, quad = lane >> 4;
    const int b = u & 3, t0 = (u >> 2) * 8;
    const size_t rowb = (size_t)b * SEQ;
    if (t0 < 256) {
#pragma unroll
        for (int h = 0; h < 2; ++h) {
            const int t = t0 + w + 4 * h;
            const int lo = lane * 64;
            const u64 m = (t >= lo + 63) ? ~0ull : (t < lo ? 0ull : ((1ull << (t - lo + 1)) - 1ull));
            __hip_atomic_store(&p.MASK[(rowb + t) * 64 + lane], m, __ATOMIC_RELAXED, __HIP_MEMORY_SCOPE_AGENT);
        }
        dep_signal(DEP_IDX(p) + b * 128 + (t0 >> 5));
        return;
    }
    unsigned short* sc = (unsigned short*)smem;
    const int ntile = (t0 + 7) / 16 + 1;
    {
        bf16x8 a[2][2];
        float4 wq[2];
#pragma unroll
        for (int rt = 0; rt < 2; ++rt) {
            const bf16_t* qa = HM(40 + (l & 3), rowb + t0 + 4 * rt + (l >> 2)) + quad * 8;
            a[rt][0] = *(const bf16x8*)qa;
            a[rt][1] = *(const bf16x8*)(qa + 32);
            wq[rt] = *(const float4*)(p.WI + (rowb + t0 + 4 * rt + quad) * 4);
        }
        const bf16_t* kb = HM(44, 0) + (rowb >> 4) * 1024 + lane * 8;
        constexpr int CH = 5;
        const int nmine = (ntile - w + 3) >> 2;
        const int nchunk = (nmine + CH - 1) / CH;
        auto loadc = [&](int c, bf16x8 (&r0)[CH], bf16x8 (&r1)[CH]) {
#pragma unroll
            for (int uu = 0; uu < CH; ++uu) {
                int i = c * CH + uu;
                i = i < nmine ? i : nmine - 1;
                i = i < 0 ? 0 : i;
                const bf16_t* kr = kb + (size_t)(w + 4 * i) * 1024;
                r0[uu] = *(const bf16x8*)kr;
                r1[uu] = *(const bf16x8*)(kr + 512);
            }
        };
        auto compc = [&](int c, const bf16x8 (&r0)[CH], const bf16x8 (&r1)[CH]) {
#pragma unroll
            for (int uu = 0; uu < CH; ++uu) {
                const int i = c * CH + uu;
                if (i < nmine) {
#pragma unroll
                    for (int rt = 0; rt < 2; ++rt) {
                        f32x4 s = (f32x4){0.f, 0.f, 0.f, 0.f};
                        s = MFMA(a[rt][0], r0[uu], s);
                        s = MFMA(a[rt][1], r1[uu], s);
                        const float v = fmaxf(s[0], 0.f) * wq[rt].x + fmaxf(s[1], 0.f) * wq[rt].y + fmaxf(s[2], 0.f) * wq[rt].z +
                                        fmaxf(s[3], 0.f) * wq[rt].w;
                        const _Float16 hv = (_Float16)v;
                        unsigned k = (unsigned)__builtin_bit_cast(unsigned short, hv);
                        if (k == 0x8000u) k = 0u;
                        k ^= (k & 0x8000u) ? 0xFFFFu : 0x8000u;
                        sc[(4 * rt + quad) * 4096 + (w + 4 * i) * 16 + l] = (unsigned short)k;
                    }
                }
            }
        };
        bf16x8 A0[CH], A1[CH], B0[CH], B1[CH];
        loadc(0, A0, A1);
        loadc(1, B0, B1);
        asm volatile("" ::"v"(a[0][0]), "v"(a[0][1]), "v"(a[1][0]), "v"(a[1][1]));
        asm volatile("" ::"v"(wq[0].x), "v"(wq[0].y), "v"(wq[0].z), "v"(wq[0].w), "v"(wq[1].x), "v"(wq[1].y), "v"(wq[1].z), "v"(wq[1].w));
#pragma unroll 1
        for (int c = 0; c < nchunk; c += 2) {
            compc(c, A0, A1);
            loadc(c + 2, A0, A1);
            compc(c + 1, B0, B1);
            loadc(c + 3, B0, B1);
        }
    }
    __syncthreads();
#pragma unroll 1
    for (int h = 0; h < 2; ++h) {
        const int qq = w + 4 * h, t = t0 + qq;
        const int nregs = (t >> 6) + 1;
        const int ngrp = (nregs + 7) >> 3;
        unsigned key[64];
#pragma unroll
        for (int i = 0; i < 64; ++i) {
            const int kpos = i * 64 + lane;
            const unsigned k16 = sc[qq * 4096 + kpos];
            key[i] = (kpos <= t) ? ((k16 << 12) | (unsigned)(4095 - kpos)) : 0u;
        }
        unsigned Tt = 0;
        for (int bit = 27; bit >= 0; --bit) {
            const unsigned cand = Tt | (1u << bit);
            int cnt = 0;
#pragma unroll
            for (int g = 0; g < 8; ++g) {
                if (g < ngrp) {
                    u64 bb[8];
#pragma unroll
                    for (int i = 0; i < 8; ++i)
                        asm("v_cmp_ge_u32_e64 %0, %1, %2" : "=s"(bb[i]) : "v"(key[g * 8 + i]), "v"(cand));
                    __builtin_amdgcn_sched_barrier(0);
#pragma unroll
                    for (int i = 0; i < 8; ++i) cnt += __builtin_popcountll(bb[i]);
                    __builtin_amdgcn_sched_barrier(0);
                }
            }
            if (cnt >= 256) {
                Tt = cand;
                if (cnt == 256) break;
            }
        }
        u64 mine = 0;
#pragma unroll
        for (int i = 0; i < 64; ++i) {
            const u64 m = __ballot(key[i] >= Tt && Tt != 0u);
            if (lane == i) mine = m;
        }
        __hip_atomic_store(&p.MASK[(rowb + t) * 64 + lane], mine, __ATOMIC_RELAXED, __HIP_MEMORY_SCOPE_AGENT);
    }
    dep_signal(DEP_IDX(p) + b * 128 + (t0 >> 5));
    __syncthreads();
}

__device__ __forceinline__ unsigned hw_xcc_id() { return (unsigned)__builtin_amdgcn_s_getreg((3 << 11) | 20) & 0xFu; }

__device__ __forceinline__ int next_item_xcd(int* ctr, int* slot, int& q, int& tries, int qlen) {
    for (;;) {
        __syncthreads();
        if (threadIdx.x == 0) *slot = atomicAdd(ctr + q * 16, 1);
        __syncthreads();
        const int it = *slot;
        if (it < qlen) return it;
        if (++tries >= 8) return -1;
        q = (q + 1) & 7;
    }
}

__device__ void phase1(const Params& p, char* smem, int* ctr) {
    int* slot = (int*)(smem + SMEM_BYTES - 16);
    int q = hw_xcc_id() & 7, tries = 0;
    for (;;) {
        const int it = next_item_xcd(ctr, slot, q, tries, 432);
        if (it < 0) break;
        const int half = it / 216, r = it % 216;
        gemm_tile<0>(p.h, p.WinT, (q * 16 + half * 8 + (r & 7)) * 128, (r >> 3) * 128, smem, p);
    }
}
__device__ void phase4(const Params& p, char* smem, int* ctr) {
    int* slot = (int*)(smem + SMEM_BYTES - 16);
    int q = hw_xcc_id() & 7, tries = 0;
    for (;;) {
        const int it = next_item_xcd(ctr, slot, q, tries, 128);
        if (it < 0) break;
        const int rk = (it >> 3) * 8 + q;
        const int mt = (rk & 3) * 32 + 31 - (rk >> 2);
        dep_wait(DEP_WORDS(p) + mt, 16u);
        gemm_tile<1>(p.MIX, p.WoutT, mt * 128, (it & 7) * 128, smem, p);
    }
}

__device__ void phase2(const Params& p, char* smem, int* ctr) {
    int* slot = (int*)(smem + SMEM_BYTES - 16);
    int q = hw_xcc_id() & 7, tries = 0;
    for (;;) {
        const int it = next_item_xcd(ctr, slot, q, tries, 32 + 256);
        if (it < 0) break;
        if (it < 32) compress_item(p, smem, q * 32 + it);
        else {
            const int i = it - 32;
            const int oct = 511 - (2 * i + (q & 1));
            indexer_item(p, smem, (oct << 2) | (q >> 1));
        }
    }
}

constexpr int KV_LD = 72;
constexpr int KV_TILE = 64 * KV_LD;

template <int RT>
struct RangeMask {
    int t[RT];
    int hi[RT], lo[RT], m0[RT];
    u64 selm[RT];
    int mode;
    int tmin, tmax;
    static constexpr bool HAS_SIMPLE = true;
    __device__ __forceinline__ bool simple(int j) const {
        if (mode == 0) return (j * 64 + 63) * 16 + 31 <= tmin;
        if (mode == 1) return j * 64 + 63 <= tmin;
        return (j * 64 + 63 <= tmin) && (j * 64 > tmax - 512);
    }
    __device__ __forceinline__ int m0s(int rt) const { return m0[rt]; }
    __device__ __forceinline__ void ld(int) {}
    __device__ __forceinline__ void st(int) {}
    __device__ __forceinline__ void begin_tile(int j, int) {
#pragma unroll
        for (int rt = 0; rt < RT; ++rt) {
            if (mode == 0) { hi[rt] = ((t[rt] - 31) >> 4) - j * 64; lo[rt] = -1; m0[rt] = -1; }
            else if (mode == 1) { hi[rt] = t[rt] - j * 64; lo[rt] = -1; m0[rt] = -(int)((selm[rt] >> j) & 1ull); }
            else { hi[rt] = t[rt] - j * 64; lo[rt] = hi[rt] - 512; m0[rt] = -1; }
        }
    }
    __device__ __forceinline__ int mask(int rt, int key) const { return (key <= hi[rt] && key > lo[rt]) ? m0[rt] : 0; }
};

template <int RT>
struct BitMask {
    const u64* gsrc;
    u64* lds;
    int slot;
    int qidx[RT];
    u64 reg;
    unsigned lo[RT], hi[RT];
    int quad4;
    static constexpr bool HAS_SIMPLE = false;
    __device__ __forceinline__ bool simple(int) const { return false; }
    __device__ __forceinline__ int m0s(int) const { return -1; }
    __device__ __forceinline__ void ld(int j) { reg = gsrc[j]; }
    __device__ __forceinline__ void st(int buf) { lds[buf * 32 + slot] = reg; }
    __device__ __forceinline__ void begin_tile(int, int buf) {
#pragma unroll
        for (int rt = 0; rt < RT; ++rt) {
            const u64 wv = lds[buf * 32 + qidx[rt]];
            lo[rt] = ((unsigned)wv) >> quad4;
            hi[rt] = ((unsigned)(wv >> 32)) >> quad4;
        }
    }
    __device__ __forceinline__ int mask(int rt, int key) const {
        const unsigned wv = (key & 32) ? hi[rt] : lo[rt];
        const int sh = (key & 31) - quad4;
        int m = __builtin_amdgcn_sbfe((int)wv, sh, 1);
        asm("" : "+v"(m));
        return m;
    }
};

template <int RT, bool DO_PV, bool HOOK, bool HAS_OFF, bool SIMPLE, class F, class H>
__device__ __forceinline__ void attn_tiles(const bf16_t* __restrict__ Kg, int kstride, const bf16_t* __restrict__ Vg, int vstride,
                                           int jb, int je, const bf16x8 (&qf)[RT][2], f32x4 (&OT)[RT][4], float (&lsum)[RT],
                                           const float (&off)[RT], bf16_t* Ks, bf16_t* Vs, F& f, H hook) {
    const int tid = threadIdx.x, lane = tid & 63, l = lane & 15, quad = lane >> 4;
    const int srow = tid >> 3, scol = (tid & 7) * 8;
    if (jb > je) return;
    bf16x8 rk[2], rv[2];
    const bf16_t* kg = Kg + (size_t)srow * kstride + scol;
    const bf16_t* vg = Vg + (size_t)srow * vstride + scol;
#pragma unroll
    for (int i = 0; i < 2; ++i) {
        rk[i] = *(const bf16x8*)(kg + (size_t)(jb * 64 + 32 * i) * kstride);
        rv[i] = *(const bf16x8*)(vg + (size_t)(32 * i) * vstride + jb * 64);
    }
    f.ld(jb);
#pragma unroll
    for (int rt = 0; rt < RT; ++rt) asm volatile("" ::"v"(qf[rt][0]), "v"(qf[rt][1]));
#pragma unroll
    for (int i = 0; i < 2; ++i) {
        *(bf16x8*)(Ks + (srow + 32 * i) * KV_LD + scol) = rk[i];
        *(bf16x8*)(Vs + (srow + 32 * i) * KV_LD + scol) = rv[i];
    }
    f.st(0);
    {
        const int jn = jb < je ? jb + 1 : je;
#pragma unroll
        for (int i = 0; i < 2; ++i) {
            rk[i] = *(const bf16x8*)(kg + (size_t)(jn * 64 + 32 * i) * kstride);
            rv[i] = *(const bf16x8*)(vg + (size_t)(32 * i) * vstride + jn * 64);
        }
        f.ld(jn);
    }
    __syncthreads();
#pragma unroll 1
    for (int j = jb; j <= je; ++j) {
        const int cur = (j - jb) & 1;
        {
            const int nx = cur ^ 1;
#pragma unroll
            for (int i = 0; i < 2; ++i) {
                *(bf16x8*)(Ks + nx * KV_TILE + (srow + 32 * i) * KV_LD + scol) = rk[i];
                *(bf16x8*)(Vs + nx * KV_TILE + (srow + 32 * i) * KV_LD + scol) = rv[i];
            }
            f.st(nx);
            const int jn = j + 2 <= je ? j + 2 : je;
#pragma unroll
            for (int i = 0; i < 2; ++i) {
                rk[i] = *(const bf16x8*)(kg + (size_t)(jn * 64 + 32 * i) * kstride);
                rv[i] = *(const bf16x8*)(vg + (size_t)(32 * i) * vstride + jn * 64);
            }
            f.ld(jn);
        }
        f.begin_tile(j, cur);
        {
        const bf16_t* Kb = Ks + cur * KV_TILE + l * KV_LD + quad * 8;
        const bf16_t* Vb = Vs + cur * KV_TILE + l * KV_LD + quad * 4;
#pragma unroll
        for (int np = 0; np < 2; ++np) {
            f32x4 S[RT][2];
#pragma unroll
            for (int n2 = 0; n2 < 2; ++n2) {
                const int nt = np * 2 + n2;
                const bf16x8 k0 = *(const bf16x8*)(Kb + nt * 16 * KV_LD), k1 = *(const bf16x8*)(Kb + nt * 16 * KV_LD + 32);
#pragma unroll
                for (int rt = 0; rt < RT; ++rt) {
                    f32x4 s = (f32x4){0.f, 0.f, 0.f, 0.f};
                    s = MFMA(k0, qf[rt][0], s);
                    S[rt][n2] = MFMA(k1, qf[rt][1], s);
                }
            }
            bf16x8 pb[RT];
#pragma unroll
            for (int rt = 0; rt < RT; ++rt) {
                float pr[8];
#pragma unroll
                for (int n2 = 0; n2 < 2; ++n2)
#pragma unroll
                    for (int r = 0; r < 4; ++r) {
                        const float e = fast_exp2(HAS_OFF ? S[rt][n2][r] + off[rt] : S[rt][n2][r]);
                        const int m = SIMPLE ? f.m0s(rt) : f.mask(rt, (np * 2 + n2) * 16 + quad * 4 + r);
                        const float pv = __int_as_float(__float_as_int(e) & m);
                        pr[n2 * 4 + r] = pv;
                        lsum[rt] += pv;
                    }
                if (HOOK) {
                    hook(rt, j, np * 2, &pr[0]);
                    hook(rt, j, np * 2 + 1, &pr[4]);
                }
                union { bf16x8 v; unsigned u[4]; } pk;
                pk.u[0] = cvt_pk_bf16(pr[0], pr[1]);
                pk.u[1] = cvt_pk_bf16(pr[2], pr[3]);
                pk.u[2] = cvt_pk_bf16(pr[4], pr[5]);
                pk.u[3] = cvt_pk_bf16(pr[6], pr[7]);
                pb[rt] = pk.v;
            }
            if (DO_PV) {
#pragma unroll
                for (int dt = 0; dt < 4; ++dt) {
                    union { bf16x8 v; uint2 h[2]; } va;
                    va.h[0] = *(const uint2*)(Vb + dt * 16 * KV_LD + (np * 2) * 16);
                    va.h[1] = *(const uint2*)(Vb + dt * 16 * KV_LD + (np * 2 + 1) * 16);
#pragma unroll
                    for (int rt = 0; rt < RT; ++rt) OT[rt][dt] = MFMA(va.v, pb[rt], OT[rt][dt]);
                }
            }
        }
        }
        __syncthreads();
    }
}

template <int RT>
__device__ __forceinline__ void zeroOT(f32x4 (&O)[RT][4]) {
#pragma unroll
    for (int a = 0; a < RT; ++a)
#pragma unroll
        for (int i = 0; i < 4; ++i) O[a][i] = (f32x4){0.f, 0.f, 0.f, 0.f};
}
__device__ __forceinline__ float quadsum(float v) {
    v += __shfl_xor(v, 16);
    v += __shfl_xor(v, 32);
    return v;
}

__device__ void nsa_item(const Params& p, char* smem, int b, int g, int qt32) {
    constexpr int RT = 2;
    dep_wait(DEP_CMP(p), 256u);
    const int tid = threadIdx.x, lane = tid & 63, w = __builtin_amdgcn_readfirstlane(tid >> 6), l = lane & 15, quad = lane >> 4;
    bf16_t* Ks = (bf16_t*)smem;
    bf16_t* Vs = Ks + 2 * KV_TILE;
    float* impq = (float*)(smem + 4 * KV_TILE * 2) + w * (8 * 64 + 8 * 65);
    float* impb = impq + 8 * 64;
    const int t0b = qt32 * 32, tw0 = t0b + 8 * w;
    const int hl = l & 3;
    const int cur = t0b >> 6;
    const size_t rowb = (size_t)b * SEQ;
    int tq[RT];
    bf16x8 qf[RT][2];
#pragma unroll
    for (int rt = 0; rt < RT; ++rt) {
        tq[rt] = tw0 + 4 * rt + (l >> 2);
        const bf16_t* qp = HM(g * 4 + hl, rowb + tq[rt]) + quad * 8;
        qf[rt][0] = *(const bf16x8*)qp;
        qf[rt][1] = *(const bf16x8*)(qp + 32);
    }
    f32x4 OT[RT][4];
    float lsum[RT], off[RT], zoff[RT];
#pragma unroll
    for (int rt = 0; rt < RT; ++rt) zoff[rt] = 0.f;
    auto nohook = [](int, int, int, const float*) {};
    RangeMask<RT> rm;
#pragma unroll
    for (int rt = 0; rt < RT; ++rt) { rm.t[rt] = tq[rt]; rm.selm[rt] = 0; }
    rm.tmin = t0b;
    rm.tmax = t0b + 31;
    auto flush = [&](const int br, const float (&fct)[RT]) {
#pragma unroll
        for (int rt = 0; rt < RT; ++rt) {
            uint2 pvv[4], zvv[4];
            bf16_t* op = p.MIX + (rowb + tq[rt]) * DM + (g * 4 + hl) * 64 + quad * 4;
            const bf16_t* zp = HM(20 + g * 4 + hl, rowb + tq[rt]) + quad * 4;
#pragma unroll
            for (int dt = 0; dt < 4; ++dt) {
                pvv[dt] = (br > 0) ? *(const uint2*)(op + dt * 16) : make_uint2(0u, 0u);
                zvv[dt] = (br == 2) ? *(const uint2*)(zp + dt * 16) : make_uint2(0u, 0u);
            }
#pragma unroll
            for (int dt = 0; dt < 4; ++dt) {
                float v0 = OT[rt][dt][0] * fct[rt], v1 = OT[rt][dt][1] * fct[rt], v2 = OT[rt][dt][2] * fct[rt], v3 = OT[rt][dt][3] * fct[rt];
                if (br > 0) {
                    const uint2 pv = pvv[dt];
                    v0 += __uint_as_float(pv.x << 16); v1 += __uint_as_float(pv.x & 0xffff0000u);
                    v2 += __uint_as_float(pv.y << 16); v3 += __uint_as_float(pv.y & 0xffff0000u);
                }
                if (br == 2) {
                    const uint2 z = zvv[dt];
                    v0 *= __uint_as_float(z.x << 16); v1 *= __uint_as_float(z.x & 0xffff0000u);
                    v2 *= __uint_as_float(z.y << 16); v3 *= __uint_as_float(z.y & 0xffff0000u);
                }
                uint2 o;
                o.x = cvt_pk_bf16(v0, v1);
                o.y = cvt_pk_bf16(v2, v3);
                if (br == 2) __hip_atomic_store((u64*)(op + dt * 16), ((u64)o.y << 32) | o.x, __ATOMIC_RELAXED, __HIP_MEMORY_SCOPE_AGENT);
                else *(uint2*)(op + dt * 16) = o;
            }
        }
    };
    float gts[RT][3];
#pragma unroll
    for (int rt = 0; rt < RT; ++rt)
#pragma unroll
        for (int br = 0; br < 3; ++br) gts[rt][br] = p.G[(rowb + tq[rt]) * 24 + (g * 4 + hl) * 3 + br];
    auto gatev = [&](int rt, int br) { return gts[rt][br]; };
    const int ncmp = (t0b >> 10) + 1;
    const bf16_t* Kc = p.KCc + ((size_t)b * 2 + g) * 256 * 64;
    const bf16_t* Vc = p.VCcT + ((size_t)b * 2 + g) * 64 * 256;
    rm.mode = 0;
#pragma unroll
    for (int rt = 0; rt < RT; ++rt) lsum[rt] = 0.f;
    zeroOT<RT>(OT);
    attn_tiles<RT, false, false, false, false>(Kc, 64, Vc, 256, 0, ncmp - 1, qf, OT, lsum, zoff, Ks, Vs, rm, nohook);
#pragma unroll
    for (int rt = 0; rt < RT; ++rt) {
        const float cs = quadsum(lsum[rt]);
        off[rt] = cs > 0.f ? -__log2f(cs) : 0.f;
        lsum[rt] = 0.f;
    }
    attn_tiles<RT, true, true, true, false>(Kc, 64, Vc, 256, 0, ncmp - 1, qf, OT, lsum, off, Ks, Vs, rm,
                               [&](int rt, int j, int nt, const float* pr) {
                                   float a = pr[0] + pr[1] + pr[2] + 0.5f * pr[3], bq = 0.5f * pr[3];
                                   a += __shfl_xor(a, 1);
                                   a += __shfl_xor(a, 2);
                                   bq += __shfl_xor(bq, 1);
                                   bq += __shfl_xor(bq, 2);
                                   if (hl == 0) {
                                       const int q = rt * 4 + (l >> 2), jj = j * 16 + nt * 4 + quad;
                                       impq[q * 64 + jj] = a;
                                       impb[q * 65 + jj + 1] = bq;
                                   }
                               });
    {
        float fct[RT];
#pragma unroll
        for (int rt = 0; rt < RT; ++rt) fct[rt] = gatev(rt, 0);
        flush(0, fct);
    }
#pragma unroll
    for (int rt = 0; rt < RT; ++rt) {
        u64 mysel = 0;
#pragma unroll 1
        for (int qq = 0; qq < 4; ++qq) {
            const int q = rt * 4 + qq;
            const int t = tw0 + q;
            const int j = lane;
            float v = 0.f;
            if (j < ncmp * 16) v = impq[q * 64 + j];
            if (j > 0 && j <= ncmp * 16) v += impb[q * 65 + j];
            if (j == 0 || j == cur || j == cur - 1) v = 1e6f;
            if (j * 64 > t) v = -1e30f;
            int rank = 0;
#pragma unroll
            for (int i = 0; i < 64; ++i) {
                const float vi = __int_as_float(__builtin_amdgcn_readlane(__float_as_int(v), i));
                rank += (vi > v || (vi == v && i < j)) ? 1 : 0;
            }
            const u64 m = __ballot(rank < 16);
            if ((l >> 2) == qq) mysel = m;
        }
        rm.selm[rt] = mysel;
    }
    rm.mode = 1;
#pragma unroll
    for (int rt = 0; rt < RT; ++rt) lsum[rt] = 0.f;
    zeroOT<RT>(OT);
    attn_tiles<RT, true, false, false, true>(HM(12 + g, rowb), 64, p.VT + (((size_t)0 * 4 + b) * 2 + g) * 64 * SEQ, SEQ, 0, cur - 1,
                                qf, OT, lsum, zoff, Ks, Vs, rm, nohook);
    attn_tiles<RT, true, false, false, false>(HM(12 + g, rowb), 64, p.VT + (((size_t)0 * 4 + b) * 2 + g) * 64 * SEQ, SEQ, cur, cur,
                                qf, OT, lsum, zoff, Ks, Vs, rm, nohook);
    {
        float fct[RT];
#pragma unroll
        for (int rt = 0; rt < RT; ++rt) { const float s = quadsum(lsum[rt]); fct[rt] = s > 0.f ? gatev(rt, 1) / s : 0.f; }
        flush(1, fct);
    }
    rm.mode = 2;
#pragma unroll
    for (int rt = 0; rt < RT; ++rt) lsum[rt] = 0.f;
    zeroOT<RT>(OT);
    attn_tiles<RT, true, false, false, false>(HM(16 + g, rowb), 64, p.VT + (((size_t)1 * 4 + b) * 2 + g) * 64 * SEQ, SEQ,
                                (t0b >= 511) ? ((t0b - 511) >> 6) : 0, cur, qf, OT, lsum, zoff, Ks, Vs, rm, nohook);
    {
        float fct[RT];
#pragma unroll
        for (int rt = 0; rt < RT; ++rt) { const float s = quadsum(lsum[rt]); fct[rt] = s > 0.f ? gatev(rt, 2) / s : 0.f; }
        flush(2, fct);
    }
    dep_signal(DEP_WORDS(p) + ((b * SEQ + t0b) >> 7));
}

__device__ void dsa_item(const Params& p, char* smem, int b, int g, int qt32) {
    constexpr int RT = 2;
    dep_wait(DEP_IDX(p) + b * 128 + qt32, 4u);
    const int tid = threadIdx.x, lane = tid & 63, w = __builtin_amdgcn_readfirstlane(tid >> 6), l = lane & 15, quad = lane >> 4;
    bf16_t* Ks = (bf16_t*)smem;
    bf16_t* Vs = Ks + 2 * KV_TILE;
    const int t0b = qt32 * 32, tw0 = t0b + 8 * w;
    const int hl = l & 3;
    const int cur = t0b >> 6;
    const size_t rowb = (size_t)b * SEQ;
    int tq[RT];
    bf16x8 qf[RT][2];
    BitMask<RT> bm;
    bm.quad4 = quad * 4;
    bm.slot = tid & 31;
    bm.lds = (u64*)(smem + 4 * KV_TILE * 2 + 4 * (8 * 64 + 8 * 65) * 4);
    bm.gsrc = p.MASK + (rowb + t0b + (tid & 31)) * 64;
#pragma unroll
    for (int rt = 0; rt < RT; ++rt) {
        tq[rt] = tw0 + 4 * rt + (l >> 2);
        const bf16_t* qp = HM(28 + g * 4 + hl, rowb + tq[rt]) + quad * 8;
        qf[rt][0] = *(const bf16x8*)qp;
        qf[rt][1] = *(const bf16x8*)(qp + 32);
        bm.qidx[rt] = 8 * w + 4 * rt + (l >> 2);
    }
    f32x4 OT[RT][4];
    float lsum[RT], zoff[RT];
#pragma unroll
    for (int rt = 0; rt < RT; ++rt) { lsum[rt] = 0.f; zoff[rt] = 0.f; }
    zeroOT<RT>(OT);
    auto nohook = [](int, int, int, const float*) {};
    attn_tiles<RT, true, false, false, false>(HM(36 + g, rowb), 64, p.VT + (((size_t)2 * 4 + b) * 2 + g) * 64 * SEQ, SEQ, 0, cur, qf,
                                OT, lsum, zoff, Ks, Vs, bm, nohook);
    uint2 zvv[RT][4];
#pragma unroll
    for (int rt = 0; rt < RT; ++rt) {
        const bf16_t* zp = HM(45 + g * 4 + hl, rowb + tq[rt]) + quad * 4;
#pragma unroll
        for (int dt = 0; dt < 4; ++dt) zvv[rt][dt] = *(const uint2*)(zp + dt * 16);
    }
#pragma unroll
    for (int rt = 0; rt < RT; ++rt) {
        const float s = quadsum(lsum[rt]);
        const float fct = s > 0.f ? 1.f / s : 0.f;
        bf16_t* op = p.MIX + (rowb + tq[rt]) * DM + 512 + (g * 4 + hl) * 64 + quad * 4;
#pragma unroll
        for (int dt = 0; dt < 4; ++dt) {
            const uint2 z = zvv[rt][dt];
            uint2 o;
            o.x = cvt_pk_bf16(OT[rt][dt][0] * fct * __uint_as_float(z.x << 16), OT[rt][dt][1] * fct * __uint_as_float(z.x & 0xffff0000u));
            o.y = cvt_pk_bf16(OT[rt][dt][2] * fct * __uint_as_float(z.y << 16), OT[rt][dt][3] * fct * __uint_as_float(z.y & 0xffff0000u));
            __hip_atomic_store((u64*)(op + dt * 16), ((u64)o.y << 32) | o.x, __ATOMIC_RELAXED, __HIP_MEMORY_SCOPE_AGENT);
        }
    }
    dep_signal(DEP_WORDS(p) + ((b * SEQ + t0b) >> 7));
}

__device__ __forceinline__ int next_item(int* ctr, int* slot) {
    __syncthreads();
    if (threadIdx.x == 0) *slot = atomicAdd(ctr, 1);
    __syncthreads();
    return *slot;
}

__device__ void phase3(const Params& p, char* smem, int* ctr) {
    int* slot = (int*)(smem + SMEM_BYTES - 16);
    int q = hw_xcc_id() & 7, tries = 0;
    for (;;) {
        const int it = next_item_xcd(ctr, slot, q, tries, 256);
        if (it < 0) break;
        const int qt = 127 - (it >> 1);
        if (it & 1) nsa_item(p, smem, q >> 1, q & 1, qt);
        else dsa_item(p, smem, q >> 1, q & 1, qt);
    }
}

#define XB_TMO      128
#define XB_XCNT(j)  (256  + 64 * (j))
#define XB_XSUB(j)  (1280 + 64 * (j))
#define XB_XGEN(j)  (2304 + 64 * (j))
#define XB_TOP      3328
#define XB_TOPGEN   3392
#define XCD_BAR_WORDS 3456
#define XB_SPIN_CAP (1u << 18)
#define LAS __attribute__((address_space(3)))

__device__ __forceinline__ unsigned xb_ld(unsigned* p)              { return __hip_atomic_load(p, __ATOMIC_RELAXED, __HIP_MEMORY_SCOPE_AGENT); }
__device__ __forceinline__ unsigned xb_add(unsigned* p, unsigned v) { return __hip_atomic_fetch_add(p, v, __ATOMIC_RELAXED, __HIP_MEMORY_SCOPE_AGENT); }
__device__ __forceinline__ unsigned xb_xcc_id() { return (unsigned)__builtin_amdgcn_s_getreg((3 << 11) | 20) & 0xFu; }
#define XB_SPIN(cond, bar) do { unsigned _sp = 0; while (cond) { __builtin_amdgcn_s_sleep(1); \
    if ((++_sp & 255u) == 0u) { if (xb_ld(&(bar)[XB_TMO])) break; if (_sp > XB_SPIN_CAP) { atomicAdd(&(bar)[XB_TMO], 1u); break; } } } } while (0)

struct XcdBarrier {
    unsigned* bar; unsigned x;
    volatile LAS unsigned* st;
};

__device__ __forceinline__ XcdBarrier xcd_barrier_post(unsigned* bar, volatile LAS unsigned* st) {
    XcdBarrier b; b.bar = bar; b.x = xb_xcc_id(); b.st = st;
    if (threadIdx.x == 0) (void)xb_add(&bar[XB_XCNT(b.x)], 1u);
    return b;
}
__device__ __forceinline__ void xcd_barrier_complete(unsigned* bar, unsigned x, unsigned& nloc, unsigned& nx) {
    const unsigned G = gridDim.x * gridDim.y * gridDim.z;
    unsigned sum, cnt, mine, sp = 0u;
    for (;;) {
        sum = 0u; cnt = 0u; mine = 0u;
#pragma unroll
        for (unsigned j = 0; j < 16; ++j) { const unsigned c = xb_ld(&bar[XB_XCNT(j)]); sum += c; cnt += (c > 0u) ? 1u : 0u; mine = (j == x) ? c : mine; }
        if (sum == G) break;
        __builtin_amdgcn_s_sleep(1);
        if ((++sp & 255u) == 0u) { if (xb_ld(&bar[XB_TMO])) break; if (sp > XB_SPIN_CAP) { atomicAdd(&bar[XB_TMO], 1u); break; } }
    }
    nloc = mine > 0u ? mine : 1u; nx = cnt > 0u ? cnt : 1u;
}

__device__ __forceinline__ void xcd_barrier(const XcdBarrier& b) {
    asm volatile("s_waitcnt vmcnt(0)" ::: "memory");
    __syncthreads();
    if (threadIdx.x == 0) {
        unsigned* bar = b.bar;
        __builtin_amdgcn_s_waitcnt(0);
        unsigned nloc = b.st[0], nx = b.st[1];
        if (nloc == 0u) { xcd_barrier_complete(bar, b.x, nloc, nx); b.st[0] = nloc; b.st[1] = nx; }
        const unsigned old = xb_add(&bar[XB_XSUB(b.x)], 1u);
        const unsigned gen = old / nloc;
        if (old + 1u == (gen + 1u) * nloc) {
            __builtin_amdgcn_fence(__ATOMIC_RELEASE, "agent");
            asm volatile("s_waitcnt vmcnt(0)" ::: "memory");
            const unsigned og = xb_add(&bar[XB_TOP], 1u);
            const unsigned tg = og / nx;
            if (og + 1u == (tg + 1u) * nx) xb_add(&bar[XB_TOPGEN], 1u);
            else XB_SPIN(xb_ld(&bar[XB_TOPGEN]) == tg, bar);
            __builtin_amdgcn_fence(__ATOMIC_ACQUIRE, "agent");
            xb_add(&bar[XB_XGEN(b.x)], 1u);
            asm volatile("s_waitcnt vmcnt(0)" ::: "memory");
        } else {
            XB_SPIN(xb_ld(&bar[XB_XGEN(b.x)]) == gen, bar);
            __builtin_amdgcn_fence(__ATOMIC_ACQUIRE, "agent");
            asm volatile("s_waitcnt vmcnt(0)" ::: "memory");
        }
    }
    __syncthreads();
}


#if COOP
__global__ void __launch_bounds__(256, 2) mega(Params p) {
    __shared__ __attribute__((aligned(16))) char smem[SMEM_BYTES];
    __shared__ uint4 xb_words;
    cg::grid_group grid = cg::this_grid();
    const int bid = blockIdx.x, nb = gridDim.x;
    if (threadIdx.x == 0) xb_words = make_uint4(0u, 0u, 0u, 0u);
    __syncthreads();
    XcdBarrier xb = xcd_barrier_post(p.bar, (volatile LAS unsigned*)&xb_words);
    if (p.bar == nullptr) grid.sync();
    phase0(p, smem, bid, nb);
    xcd_barrier(xb);
#ifndef R1
#define R1 1
#define R2 1
#define R3 1
#define R4 1
#endif
    for (int r = 0; r < R1; ++r) { phase1(p, smem, p.ctr + 256 + r * 512); xcd_barrier(xb); }
    for (int r = 0; r < R2; ++r) { phase2(p, smem, p.ctr + r * 512); }
    for (int r = 0; r < R3; ++r) { phase3(p, smem, p.ctr + 128 + r * 512); }
    for (int r = 0; r < R4; ++r) { phase4(p, smem, p.ctr + 384 + r * 512); }
}
#else
template <int PH>
__global__ void __launch_bounds__(256, 2) kphase(Params p) {
    __shared__ __attribute__((aligned(16))) char smem[SMEM_BYTES];
    const int bid = blockIdx.x, nb = gridDim.x;
    if (PH == 0) phase0(p, smem, bid, nb);
    if (PH == 1) phase1(p, smem, p.ctr + 256);
    if (PH == 2) phase2(p, smem, p.ctr);
    if (PH == 3) phase3(p, smem, p.ctr + 128);
    if (PH == 4) phase4(p, smem, p.ctr + 384);
}
#endif

extern "C" void kernel_launch(void* const* d_in, const int* in_sizes, int n_in, void* d_out, int out_size, void* d_ws,
                              size_t ws_size, hipStream_t stream) {
    Params p{};
    const float** f = (const float**)&p;
    for (int i = 0; i < 18; ++i) f[i] = (const float*)d_in[i];
    p.out = (float*)d_out;
    char* ws = (char*)d_ws;
    size_t off = 0;
    auto take = [&](size_t bytes) { char* r = ws + off; off += (bytes + 255) & ~(size_t)255; return r; };
    p.h = (bf16_t*)take((size_t)MROWS * DM * 2);
    p.WinT = (bf16_t*)take((size_t)NP * 1024 * 2);
    p.WoutT = (bf16_t*)take((size_t)1024 * 1024 * 2);
    p.W1kT = (bf16_t*)take((size_t)256 * 2048 * 2);
    p.W1vT = (bf16_t*)take((size_t)256 * 2048 * 2);
    p.W2kT = (bf16_t*)take((size_t)64 * 256 * 2);
    p.W2vT = (bf16_t*)take((size_t)64 * 256 * 2);
    p.P = (bf16_t*)take((size_t)MROWS * NP * 2);
    p.VT = (bf16_t*)take((size_t)3 * 4 * 2 * 64 * SEQ * 2);
    p.KCc = (bf16_t*)take((size_t)8 * 256 * 64 * 2);
    p.VCcT = (bf16_t*)take((size_t)8 * 64 * 256 * 2);
    p.MIX = (bf16_t*)take((size_t)MROWS * DM * 2);
    p.ropecs = (float2*)take((size_t)SEQ * 32 * 8);
    p.G = (float*)take((size_t)MROWS * 24 * 4);
    p.WI = (float*)take((size_t)MROWS * 4 * 4);
    p.MASK = (u64*)take((size_t)MROWS * 64 * 8);
    p.bar = (unsigned*)take((size_t)XCD_BAR_WORDS * 4);
    p.ctr = (int*)take(8192);
    hipMemsetAsync(p.bar, 0, (size_t)((XCD_BAR_WORDS * 4 + 255) & ~255) + 8192, stream);
#if COOP
    static int grid_blocks = 0;
    if (!grid_blocks) {
        int dev = 0, cus = 0, per_cu = 0;
        hipGetDevice(&dev);
        hipDeviceGetAttribute(&cus, hipDeviceAttributeMultiprocessorCount, dev);
        hipOccupancyMaxActiveBlocksPerMultiprocessor(&per_cu, mega, 256, 0);
        if (per_cu > 2) per_cu = 2;
        grid_blocks = cus * per_cu;
    }
    void* args[] = {&p};
    hipError_t e = hipLaunchCooperativeKernel((void*)mega, dim3(grid_blocks), dim3(256), args, 0, stream);
    if (e != hipSuccess) fprintf(stderr, "cooperative launch failed: %s (grid %d)\n", hipGetErrorString(e), grid_blocks);
#else
    const int nb = 1024;
    kphase<0><<<nb, 256, 0, stream>>>(p);
    kphase<1><<<nb, 256, 0, stream>>>(p);
    kphase<2><<<nb, 256, 0, stream>>>(p);
    kphase<3><<<nb, 256, 0, stream>>>(p);
    kphase<4><<<nb, 256, 0, stream>>>(p);
#endif
}
```
